# Optimizing an MI355X kernel written in HIP

```python
import jax, jax.numpy as jnp
from jax import lax
import numpy as np

D_MODEL = 1024
BATCH = 32
SEQ = 2048
DEPTH = 1

D_MIX = D_MODEL
D_REC = D_MIX // 2
D_POOL = D_MIX - D_REC
REC_HEAD_DIM = 128
N_REC_HEADS = D_REC // REC_HEAD_DIM
POOL_WINDOWS = (2, 4, 8, 16)
N_POOL_GROUPS = len(POOL_WINDOWS)
POOL_GROUP_DIM = D_POOL // N_POOL_GROUPS
D_IN = 4 * D_REC + D_POOL
D_FF = 4 * D_MODEL
N_MOD = 6
CHUNK = 32
EPS = 1e-6

kernel_name = "hybrid_hgrn2_pool_adaln_block"


def _rmsnorm(x, w):
    xf = x.astype(jnp.float32)
    xf = xf * lax.rsqrt(jnp.mean(xf * xf, axis=-1, keepdims=True) + EPS)
    return xf * w.astype(jnp.float32)


def _hgrn2(q, f_logit, v, g, lb, g_norm_w):
    B, T, _ = q.shape
    H, Dh, C = N_REC_HEADS, REC_HEAD_DIM, CHUNK
    n = T // C
    f32 = jnp.float32
    forget = lb + (1.0 - lb) * jax.nn.sigmoid(f_logit.astype(f32))
    k = 1.0 - forget
    logf = jnp.log(forget)
    qs = jax.nn.silu(q.astype(f32)) * (Dh ** -0.5)

    def split(a):
        return a.reshape(B, n, C, H, Dh).transpose(0, 3, 1, 2, 4)

    qs, k, vv, logf = (split(a) for a in (qs, k, v.astype(f32), logf))
    b = jnp.cumsum(logf, axis=3)
    b_ref = b[:, :, :, C // 2 - 1:C // 2]
    b_last = b[:, :, :, C - 1:C]

    scores = jnp.einsum('bhncd,bhnsd->bhncs', qs * jnp.exp(b - b_ref), k * jnp.exp(b_ref - b))
    causal = jnp.tril(jnp.ones((C, C), dtype=bool))
    scores = jnp.where(causal, scores, 0.0)
    o_intra = jnp.einsum('bhncs,bhnse->bhnce', scores, vv)

    q_in = qs * jnp.exp(b)
    k_out = k * jnp.exp(b_last - b)
    decay_chunk = jnp.exp(b_last[:, :, :, 0])

    def step(S, xs):
        q_c, k_c, v_c, d_c = xs
        o = jnp.einsum('bhcd,bhde->bhce', q_c, S)
        S = d_c[..., None] * S + jnp.einsum('bhcd,bhce->bhde', k_c, v_c)
        return S, o

    S0 = jnp.zeros((B, H, Dh, Dh), f32)
    xs = tuple(jnp.moveaxis(a, 2, 0) for a in (q_in, k_out, vv, decay_chunk))
    _, o_inter = lax.scan(step, S0, xs)
    o = o_intra + jnp.moveaxis(o_inter, 0, 2)
    o = o.transpose(0, 2, 3, 1, 4).reshape(B, T, H, Dh)

    gg = g.astype(f32).reshape(B, T, H, Dh)
    o = o * lax.rsqrt(jnp.mean(o * o, axis=-1, keepdims=True) + EPS) * g_norm_w.astype(f32) * jax.nn.silu(gg)
    return o.reshape(B, T, D_REC)


def _pool_mixer(p, w_pool, pool_scale):
    B, T, _ = p.shape
    G, Dg = N_POOL_GROUPS, POOL_GROUP_DIM
    W_MAX = max(POOL_WINDOWS)
    pf = p.astype(jnp.float32)
    cs = jnp.cumsum(pf, axis=1)
    cs_pad = jnp.pad(cs, ((0, 0), (W_MAX, 0), (0, 0)))
    pos = jnp.arange(T)
    outs = []
    for gi, w in enumerate(POOL_WINDOWS):
        sl = slice(gi * Dg, (gi + 1) * Dg)
        lower = cs_pad[:, W_MAX - w:W_MAX - w + T, sl]
        count = jnp.minimum(pos + 1, w).astype(jnp.float32)[None, :, None]
        outs.append((cs[:, :, sl] - lower) / count - pf[:, :, sl])
    pooled = jnp.stack(outs, axis=2)
    mixed = jnp.einsum('btgc,gcd->btgd', pooled, w_pool.astype(jnp.float32))
    return mixed.reshape(B, T, D_POOL) * pool_scale.astype(jnp.float32)


def setup_inputs(seed: int = 0) -> dict:
    key = jax.random.key(seed)
    ks = jax.random.split(key, 16)
    f32 = jnp.float32
    nrm = lambda k, shape, s: jax.random.normal(k, shape, f32) * s
    return {
        "x": nrm(ks[0], (BATCH, SEQ, D_MODEL), 1.0),
        "c": nrm(ks[1], (BATCH, D_MODEL), 1.0),
        "w_ada": nrm(ks[2], (DEPTH, D_MODEL, N_MOD * D_MODEL), 0.5 * D_MODEL ** -0.5),
        "b_ada": nrm(ks[3], (DEPTH, N_MOD * D_MODEL), 0.01),
        "norm_mix_w": 1.0 + nrm(ks[4], (DEPTH, D_MODEL), 0.02),
        "w_in": nrm(ks[5], (DEPTH, D_MODEL, D_IN), D_MODEL ** -0.5),
        "lb_logits": nrm(ks[6], (DEPTH + 1, D_REC), 0.1),
        "g_norm_w": 1.0 + nrm(ks[7], (DEPTH, REC_HEAD_DIM), 0.02),
        "w_pool": nrm(ks[8], (DEPTH, N_POOL_GROUPS, POOL_GROUP_DIM, POOL_GROUP_DIM), POOL_GROUP_DIM ** -0.5),
        "pool_scale": 1.0 + nrm(ks[9], (DEPTH, D_POOL), 0.02),
        "w_out": nrm(ks[10], (DEPTH, D_MIX, D_MODEL), D_MIX ** -0.5),
        "norm_mlp_w": 1.0 + nrm(ks[11], (DEPTH, D_MODEL), 0.02),
        "w_up": nrm(ks[12], (DEPTH, D_MODEL, D_FF), D_MODEL ** -0.5),
        "w_down": nrm(ks[13], (DEPTH, D_FF, D_MODEL), D_FF ** -0.5),
        "norm_final_w": 1.0 + nrm(ks[14], (D_MODEL,), 0.02),
    }


def reference(x, c, w_ada, b_ada, norm_mix_w, w_in, lb_logits, g_norm_w, w_pool, pool_scale,
              w_out, norm_mlp_w, w_up, w_down, norm_final_w):
    dtype = x.dtype
    f32 = jnp.float32
    lbs = jnp.cumsum(jax.nn.softmax(lb_logits.astype(f32), axis=0), axis=0)
    c_act = jax.nn.silu(c.astype(f32))
    h = x.astype(f32)
    for l in range(DEPTH):
        mod = c_act @ w_ada[l].astype(f32) + b_ada[l].astype(f32)
        sh_a, sc_a, gt_a, sh_m, sc_m, gt_m = (m[:, None, :] for m in jnp.split(mod, N_MOD, axis=-1))

        u = _rmsnorm(h, norm_mix_w[l]) * (1.0 + sc_a) + sh_a
        proj = u @ w_in[l].astype(f32)
        q, f_logit, v, g, p = jnp.split(proj, [D_REC, 2 * D_REC, 3 * D_REC, 4 * D_REC], axis=-1)
        o_rec = _hgrn2(q, f_logit, v, g, lbs[l], g_norm_w[l])
        o_pool = _pool_mixer(p, w_pool[l], pool_scale[l])
        mix = jnp.concatenate([o_rec, o_pool], axis=-1) @ w_out[l].astype(f32)
        h = h + gt_a * mix

        u = _rmsnorm(h, norm_mlp_w[l]) * (1.0 + sc_m) + sh_m
        hid = jnp.square(jax.nn.relu(u @ w_up[l].astype(f32)))
        h = h + gt_m * (hid @ w_down[l].astype(f32))
    return _rmsnorm(h, norm_final_w).astype(dtype)
```

```cpp
#include <hip/hip_runtime.h>
#include <hip/hip_cooperative_groups.h>
#include <cstdio>
#include <cstdint>
namespace cg = cooperative_groups;
namespace pg8 {
#define PG8_LAS __attribute__((address_space(3)))
typedef unsigned short bf16_t;
typedef short bf16x8 __attribute__((ext_vector_type(8)));
typedef float f32x4 __attribute__((ext_vector_type(4)));
typedef unsigned u32x4 __attribute__((ext_vector_type(4)));
constexpr int BM = 256, BK = 64, HALF = 128, HTB = HALF * BK * 2  , STAGE_BYTES = 8 * HTB, NXCD = 8, WGM = 8;

__host__ __device__ __forceinline__ int lds_byte(int r, int c) { const int st = (r >> 4) * 2 + (c >> 5), rr = r & 15, cc = c & 31, ob = rr * 64 + cc * 2; return st * 1024 + (ob ^ (((ob >> 9) & 1) << 5)); }
__host__ __device__ __forceinline__ void stage_rc(int b, int& R, int& C) { const int st = b / 1024, sb = b % 1024, swz = sb ^ (((sb >> 9) & 1) << 5); R = (st >> 1) * 16 + swz / 64; C = (st & 1) * 32 + (swz % 64) / 2; }
__host__ __device__ __forceinline__ int perm32(int rho) { const int n = rho >> 4, i = rho & 15; return 8 * (i >> 2) + 4 * n + (i & 3); }

struct Unit { int pm, pn; };
struct Gemm { const bf16_t* A; const bf16_t* Bt; int M, N, K; };

struct StaticOrder {
    int nM, nN, nwg, G, c;
    __host__ __device__ void init(int M, int N, int G_, int c_) { nM = M / BM; nN = N / BM; nwg = nM * nN; G = G_; c = c_; }
    __host__ __device__ bool next(int i, Unit& u) const {
        const long L = (long)i * G + c; if (L >= nwg) return false;
        int wgid = (int)L; { const int q = nwg / NXCD, r = nwg % NXCD, xcd = wgid % NXCD, off = wgid / NXCD; wgid = (xcd < r ? xcd * (q + 1) : r * (q + 1) + (xcd - r) * q) + off; }
        const int nig = WGM * nN, gid = wgid / nig, fm = gid * WGM, gsz = (nM - fm) < WGM ? (nM - fm) : WGM;
        u.pm = fm + ((wgid % nig) % gsz); u.pn = (wgid % nig) / gsz; return true;
    }
    __device__ __forceinline__ void a_ready(const Unit&) const {}
    __device__ __forceinline__ void done(const Unit&) const {}
};

__device__ __forceinline__ unsigned cvt_pk_bf16(float lo, float hi) { unsigned r; asm volatile("v_cvt_pk_bf16_f32 %0, %1, %2" : "=v"(r) : "v"(lo), "v"(hi)); return r; }
typedef float f32x2 __attribute__((ext_vector_type(2)));
__device__ __forceinline__ f32x2 gelu_pk(f32x2 v) {
    const f32x2 av = __builtin_elementwise_abs(v), d = av * 0.2316418882f + 1.0f;
    f32x2 t; t.x = __builtin_amdgcn_rcpf(d.x); t.y = __builtin_amdgcn_rcpf(d.y);
    f32x2 q = t * 0.5307027145f + (-0.7265760135f); q = q * t + 0.7107068705f; q = q * t + (-0.142248368f); q = q * t + 0.127414796f; q = q * t;
    const f32x2 s = (v * v) * (-0.72134752044f);
    f32x2 e; e.x = __builtin_amdgcn_exp2f(s.x); e.y = __builtin_amdgcn_exp2f(s.y);
    const f32x2 m = v * (q * e), r = v - m;
    f32x2 o; o.x = v.x < 0.f ? m.x : r.x; o.y = v.y < 0.f ? m.y : r.y; return o;
}

template <int ACT  > struct EpiBf16 {
    static constexpr bool PERM = true, AFTER_DRAIN = false; static_assert(ACT == 0 || ACT == 1 || ACT == 2, "EpiBf16: ACT is 0 (none), 1 (gelu_pk) or 2 (relu^2)");
    bf16_t* O; int ldc; const float* bias; int split_cols; size_t split_stride; float scale0;
    __device__ __forceinline__ void operator()(const f32x4 (&acc)[2][2][4][2], const Unit& u, int wr, int wc, int fr, int fq) const {
        const int row0 = u.pm * BM + wr * 64 + fr; int colt = u.pn * BM; bf16_t* base = O;
        float sc = 1.f; if (split_cols) { const int t = colt / split_cols; base += (size_t)t * split_stride; colt -= t * split_cols; if (t == 0) sc = scale0; }
        const int col0 = colt + wc * 32 + 8 * fq, bcol0 = u.pn * BM + wc * 32 + 8 * fq;
        f32x4 bv[2][2];
#pragma unroll
        for (int bj = 0; bj < 2; ++bj)
#pragma unroll
            for (int n = 0; n < 2; ++n) bv[bj][n] = bias ? *(const f32x4*)(bias + bcol0 + bj * HALF + 4 * n) : (f32x4){0.f, 0.f, 0.f, 0.f};
#pragma unroll
        for (int ai = 0; ai < 2; ++ai)
#pragma unroll
            for (int m = 0; m < 4; ++m) { bf16_t* rowp = base + (size_t)(row0 + ai * HALF + m * 16) * ldc + col0;
#pragma unroll
                for (int bj = 0; bj < 2; ++bj) { f32x4 v0 = acc[ai][bj][m][0] + bv[bj][0], v1 = acc[ai][bj][m][1] + bv[bj][1];
                    if (ACT == 1) { f32x2 a = gelu_pk((f32x2){v0[0], v0[1]}), b = gelu_pk((f32x2){v0[2], v0[3]}), c = gelu_pk((f32x2){v1[0], v1[1]}), d = gelu_pk((f32x2){v1[2], v1[3]});
                        v0 = (f32x4){a.x, a.y, b.x, b.y}; v1 = (f32x4){c.x, c.y, d.x, d.y}; }
                    if (ACT == 2) { v0 = __builtin_elementwise_max(v0, (f32x4){0.f, 0.f, 0.f, 0.f}); v1 = __builtin_elementwise_max(v1, (f32x4){0.f, 0.f, 0.f, 0.f}); v0 = v0 * v0; v1 = v1 * v1; }
                    v0 = v0 * sc; v1 = v1 * sc; u32x4 w; w.x = cvt_pk_bf16(v0[0], v0[1]); w.y = cvt_pk_bf16(v0[2], v0[3]); w.z = cvt_pk_bf16(v1[0], v1[1]); w.w = cvt_pk_bf16(v1[2], v1[3]);
                    *(u32x4*)(rowp + bj * HALF) = w; } }
    }
};
struct EpiResGate {
    static constexpr bool PERM = true, AFTER_DRAIN = false;
    const float* base; float* out; const float* gate; int ldc, gate_ld, tiles_per_batch;
    __device__ __forceinline__ void operator()(const f32x4 (&acc)[2][2][4][2], const Unit& u, int wr, int wc, int fr, int fq) const {
        const int row0 = u.pm * BM + wr * 64 + fr, col0 = u.pn * BM + wc * 32 + 8 * fq;
        const float* gp = gate + (size_t)(u.pm / tiles_per_batch) * gate_ld + col0;
        f32x4 gv[2][2];
#pragma unroll
        for (int bj = 0; bj < 2; ++bj)
#pragma unroll
            for (int n = 0; n < 2; ++n) gv[bj][n] = *(const f32x4*)(gp + bj * HALF + 4 * n);
#pragma unroll
        for (int ai = 0; ai < 2; ++ai)
#pragma unroll
            for (int m = 0; m < 4; ++m) { const size_t off = (size_t)(row0 + ai * HALF + m * 16) * ldc + col0;
#pragma unroll
                for (int bj = 0; bj < 2; ++bj)
#pragma unroll
                    for (int n = 0; n < 2; ++n) { const f32x4 bs = *(const f32x4*)(base + off + bj * HALF + 4 * n);
                        *(f32x4*)(out + off + bj * HALF + 4 * n) = bs + gv[bj][n] * acc[ai][bj][m][n]; }
                if (m & 1) asm volatile("" ::: "memory"); }
    }
};
template <class Epi, class Sched, bool ALIGN_EPI = false, bool SP2 = false>
__device__ __forceinline__ void gemm_phase(PG8_LAS unsigned char* lds, const Gemm g, const Sched& S, const Epi& E) {
    const int tid = threadIdx.x, wid = __builtin_amdgcn_readfirstlane(tid >> 6), lane = tid & 63, wr = wid >> 2, wc = wid & 3, fr = lane & 15, fq = lane >> 4;
    const int K = g.K, nt = K / BK;
    unsigned voffA[2], voffB[2];
#pragma unroll
    for (int i = 0; i < 2; ++i) { int R, C; stage_rc(tid * 16 + i * 8192, R, C); const int Rb = Epi::PERM ? ((R & ~31) + perm32(R & 31)) : R;
        voffA[i] = (unsigned)(R * K + C) * 2u; voffB[i] = (unsigned)(Rb * K + C) * 2u; }
    const size_t kstep = (size_t)(BK * 2);
    const size_t hstep = (size_t)HALF * K * 2;
    const size_t tstep = 2 * hstep;
    const unsigned ldsw = (unsigned)wid * 1024u;
    const int aoff = lds_byte(wr * 64 + fr, fq * 8), boff = lds_byte(wc * 32 + fr, fq * 8);
#define PG8_SA(b, h) (((b) * 2 + (h)) * HTB)
#define PG8_SB(b, h) ((4 + (b) * 2 + (h)) * HTB)
#define PG8_STAGE(bufoff, gbase, voff) do { _Pragma("unroll") for (int _i = 0; _i < 2; ++_i) \
        __builtin_amdgcn_global_load_lds((const unsigned*)((const char*)(gbase) + (voff)[_i]), (PG8_LAS unsigned*)(lds + (bufoff) + ldsw + _i * 8192), 16, 0, 0); } while (0)
#define PG8_LDA(dst, b, h) do { _Pragma("unroll") for (int m = 0; m < 4; ++m) _Pragma("unroll") for (int k = 0; k < 2; ++k) dst[m][k] = *(const PG8_LAS bf16x8*)(lds + PG8_SA(b, h) + aoff + m * 2048 + k * 1024); } while (0)
#define PG8_LDB(dst, b, h) do { _Pragma("unroll") for (int n = 0; n < 2; ++n) _Pragma("unroll") for (int k = 0; k < 2; ++k) dst[n][k] = *(const PG8_LAS bf16x8*)(lds + PG8_SB(b, h) + boff + n * 2048 + k * 1024); } while (0)
#define PG8_MMA(ai, bj, At, Bt) do { __builtin_amdgcn_s_setprio(1); _Pragma("unroll") for (int m = 0; m < 4; ++m) _Pragma("unroll") for (int n = 0; n < 2; ++n) _Pragma("unroll") for (int k = 0; k < 2; ++k) \
        acc[ai][bj][m][n] = __builtin_amdgcn_mfma_f32_16x16x32_bf16(Bt[n][k], At[m][k], acc[ai][bj][m][n], 0, 0, 0); __builtin_amdgcn_s_setprio(0); } while (0)
#define PG8_WAIT_V(n) asm volatile("s_waitcnt vmcnt(" #n ")" ::: "memory")
#define PG8_WAIT_L(n) asm volatile("s_waitcnt lgkmcnt(" #n ")" ::: "memory")
#define PG8_BAR __builtin_amdgcn_s_barrier()
#define PG8_SCHED __builtin_amdgcn_sched_barrier(0)
    Unit cur, nxt; int ui = 0;
    if (!S.next(0, cur)) return;
    f32x4 acc[2][2][4][2];
#pragma unroll
    for (int a = 0; a < 2; ++a)
#pragma unroll
        for (int b = 0; b < 2; ++b)
#pragma unroll
            for (int m = 0; m < 4; ++m)
#pragma unroll
                for (int n = 0; n < 2; ++n) acc[a][b][m][n] = (f32x4){0.f, 0.f, 0.f, 0.f};
    bf16x8 At[4][2], B0[2][2], B1[2][2];
    const char* cA = (const char*)g.A + (size_t)cur.pm * tstep; const char* cB = (const char*)g.Bt + (size_t)cur.pn * tstep;
    S.a_ready(cur);
    if constexpr (SP2) {
        PG8_STAGE(PG8_SB(0, 0), cB, voffB); PG8_STAGE(PG8_SB(0, 1), cB + hstep, voffB); PG8_STAGE(PG8_SA(0, 0), cA, voffA); PG8_STAGE(PG8_SA(0, 1), cA + hstep, voffA);
        if (wr == 1) PG8_BAR;
        PG8_WAIT_V(2); PG8_BAR;
        PG8_STAGE(PG8_SB(1, 0), cB + kstep, voffB); PG8_STAGE(PG8_SA(1, 0), cA + kstep, voffA); PG8_STAGE(PG8_SB(1, 1), cB + hstep + kstep, voffB);
        PG8_WAIT_V(6); PG8_BAR;
    } else {
        PG8_STAGE(PG8_SB(0, 0), cB, voffB); PG8_STAGE(PG8_SA(0, 0), cA, voffA); PG8_STAGE(PG8_SB(0, 1), cB + hstep, voffB); PG8_STAGE(PG8_SA(0, 1), cA + hstep, voffA);
        if (wr == 1) PG8_BAR;
        PG8_WAIT_V(4); PG8_BAR;
        PG8_STAGE(PG8_SB(1, 0), cB + kstep, voffB); PG8_STAGE(PG8_SA(1, 0), cA + kstep, voffA); PG8_STAGE(PG8_SB(1, 1), cB + hstep + kstep, voffB);
        PG8_WAIT_V(6); PG8_BAR;
    }
    for (;;) {
        const bool has_next = S.next(ui + 1, nxt);
        const char* nA = has_next ? (const char*)g.A + (size_t)nxt.pm * tstep : cA; const char* nB = has_next ? (const char*)g.Bt + (size_t)nxt.pn * tstep : cB;
        for (int t = 0; t < nt; t += 2) {
            const bool last = (t == nt - 2);
            const char* a1 = cA + (size_t)(t + 1) * kstep;
            const char* a2 = last ? nA : cA + (size_t)(t + 2) * kstep; const char* b2 = last ? nB : cB + (size_t)(t + 2) * kstep;
            const char* a3 = a2 + kstep; const char* b3 = b2 + kstep;
            if (last && has_next) S.a_ready(nxt);
            if constexpr (SP2) {
            PG8_LDB(B0, 0, 0); PG8_LDB(B1, 0, 1); PG8_SCHED; PG8_LDA(At, 0, 0); PG8_STAGE(PG8_SA(1, 1), a1 + hstep, voffA);
            PG8_WAIT_V(8); PG8_WAIT_L(0); PG8_BAR; PG8_MMA(0, 0, At, B0); PG8_MMA(0, 1, At, B1); PG8_BAR; PG8_SCHED;
            PG8_LDA(At, 0, 1); PG8_STAGE(PG8_SB(0, 0), b2, voffB); PG8_STAGE(PG8_SB(0, 1), b2 + hstep, voffB); PG8_STAGE(PG8_SA(0, 0), a2, voffA);
            PG8_WAIT_V(8); PG8_WAIT_L(0); PG8_BAR; PG8_MMA(1, 0, At, B0); PG8_MMA(1, 1, At, B1); PG8_BAR; PG8_SCHED;
            PG8_LDB(B0, 1, 0); PG8_LDB(B1, 1, 1); PG8_SCHED; PG8_LDA(At, 1, 0); PG8_STAGE(PG8_SA(0, 1), a2 + hstep, voffA);
            PG8_WAIT_V(8); PG8_WAIT_L(0); PG8_BAR; PG8_MMA(0, 0, At, B0); PG8_MMA(0, 1, At, B1); PG8_BAR; PG8_SCHED;
            PG8_LDA(At, 1, 1); PG8_STAGE(PG8_SB(1, 0), b3, voffB); PG8_STAGE(PG8_SB(1, 1), b3 + hstep, voffB); PG8_STAGE(PG8_SA(1, 0), a3, voffA);
            PG8_WAIT_V(8); PG8_WAIT_L(0); PG8_BAR; PG8_MMA(1, 0, At, B0); PG8_MMA(1, 1, At, B1); PG8_BAR; PG8_SCHED;
            } else {
            PG8_LDB(B0, 0, 0); PG8_SCHED; PG8_LDA(At, 0, 0); PG8_STAGE(PG8_SA(1, 1), a1 + hstep, voffA);
            PG8_WAIT_L(8); PG8_BAR; PG8_WAIT_L(0); PG8_MMA(0, 0, At, B0); PG8_BAR; PG8_SCHED;
            PG8_LDB(B1, 0, 1); PG8_STAGE(PG8_SB(0, 0), b2, voffB);
            PG8_BAR; PG8_WAIT_L(0); PG8_MMA(0, 1, At, B1); PG8_BAR;
            PG8_LDA(At, 0, 1); PG8_STAGE(PG8_SA(0, 0), a2, voffA);
            PG8_BAR; PG8_WAIT_L(0); PG8_MMA(1, 0, At, B0); PG8_BAR; PG8_SCHED;
            PG8_STAGE(PG8_SB(0, 1), b2 + hstep, voffB);
            PG8_WAIT_V(6); PG8_BAR; PG8_MMA(1, 1, At, B1); PG8_BAR;
            PG8_LDB(B0, 1, 0); PG8_SCHED; PG8_LDA(At, 1, 0); PG8_STAGE(PG8_SA(0, 1), a2 + hstep, voffA);
            PG8_WAIT_L(8); PG8_BAR; PG8_WAIT_L(0); PG8_MMA(0, 0, At, B0); PG8_BAR; PG8_SCHED;
            PG8_LDB(B1, 1, 1); PG8_STAGE(PG8_SB(1, 0), b3, voffB);
            PG8_BAR; PG8_WAIT_L(0); PG8_MMA(0, 1, At, B1); PG8_BAR;
            PG8_LDA(At, 1, 1); PG8_STAGE(PG8_SA(1, 0), a3, voffA);
            PG8_BAR; PG8_WAIT_L(0); PG8_MMA(1, 0, At, B0); PG8_BAR; PG8_SCHED;
            PG8_STAGE(PG8_SB(1, 1), b3 + hstep, voffB);
            PG8_WAIT_V(6); PG8_BAR; PG8_MMA(1, 1, At, B1); PG8_BAR;
            }
        }
        if constexpr (ALIGN_EPI) { if (wr == 0) PG8_BAR; }
        if constexpr (!Epi::AFTER_DRAIN) { E(acc, cur, wr, wc, fr, fq); S.done(cur); }
        if (!has_next) break;
#pragma unroll
        for (int a = 0; a < 2; ++a)
#pragma unroll
            for (int b = 0; b < 2; ++b)
#pragma unroll
                for (int m = 0; m < 4; ++m)
#pragma unroll
                    for (int n = 0; n < 2; ++n) acc[a][b][m][n] = (f32x4){0.f, 0.f, 0.f, 0.f};
        cur = nxt; cA = nA; cB = nB; ++ui;
        if constexpr (ALIGN_EPI) { if (wr == 1) PG8_BAR; }
    }
    PG8_WAIT_V(0);
    if constexpr (!ALIGN_EPI) { if (wr == 0) PG8_BAR; }
    PG8_BAR;
    if constexpr (Epi::AFTER_DRAIN) { E.fused(acc, cur, wr, wc, fr, fq, lds, wid, lane); S.done(cur); }
#undef PG8_SA
#undef PG8_SB
#undef PG8_STAGE
#undef PG8_LDA
#undef PG8_LDB
#undef PG8_MMA
#undef PG8_WAIT_V
#undef PG8_WAIT_L
#undef PG8_BAR
#undef PG8_SCHED
}
}

constexpr int NWAVES = 8, NTHREADS = NWAVES * 64;
#ifndef MK_N_LAUNCHES
#define MK_N_LAUNCHES 1
#endif
constexpr int N_PHASES = 9;
constexpr int BATCH = 32, T = 2048, D = 1024, M = BATCH * T, DIN = 2560, FF = 4096, DREC = 512, NH = 4, DH = 128, NMOD = 6 * D;
constexpr float EPS = 1e-6f;
constexpr size_t MiB = 1u << 20;
constexpr size_t WS_WIN = 2 * MiB, WS_WO = 8 * MiB, WS_WUP = 10 * MiB, WS_WDN = 18 * MiB, WS_MOD = 26 * MiB, WS_U = 32 * MiB, WS_HID = 160 * MiB, WS_PROJ = 160 * MiB, WS_MIX = 480 * MiB, WS_END = 672 * MiB;
static_assert(WS_PROJ + (size_t)M * DIN * 2 <= WS_MIX && WS_MIX + (size_t)M * D * 2 <= WS_END && WS_HID + (size_t)M * FF * 2 <= WS_END && WS_U + (size_t)M * D * 2 <= WS_HID, "d_ws map");
constexpr int LDS_BYTES = 147456;

#define LAS __attribute__((address_space(3)))
typedef unsigned short bf16;
typedef unsigned v4u __attribute__((ext_vector_type(4)));
typedef unsigned v2u __attribute__((ext_vector_type(2)));
typedef float f32x4 __attribute__((ext_vector_type(4)));
#define LDS_WAIT() asm volatile("s_waitcnt lgkmcnt(0)" ::: "memory")
__device__ __forceinline__ unsigned f2bf(float f) { unsigned u = __builtin_bit_cast(unsigned, f); return (u + 0x7fffu + ((u >> 16) & 1u)) >> 16; }
__device__ __forceinline__ unsigned pk2(float lo, float hi) { return f2bf(lo) | (f2bf(hi) << 16); }
__device__ __forceinline__ float bf2f(unsigned h) { return __builtin_bit_cast(float, h << 16); }
__device__ __forceinline__ float bflo(unsigned w) { return __builtin_bit_cast(float, w << 16); }
__device__ __forceinline__ float bfhi(unsigned w) { return __builtin_bit_cast(float, w & 0xffff0000u); }
__device__ __forceinline__ float sigmoidf_(float x) { return 1.0f / (1.0f + __expf(-x)); }
__device__ __forceinline__ float siluf_(float x) { return x / (1.0f + __expf(-x)); }
__device__ __forceinline__ float wave_sum(float v) {
#pragma unroll
    for (int o = 1; o < 64; o <<= 1) v += __shfl_xor(v, o);
    return v;
}

__device__ __forceinline__ void p0_transpose_item(const float* W, int N, bf16* WT, int ldk, LAS float* scr, int item, int lane) {
    const int nblk = N / 32, kb = item / nblk, nb = item % nblk, k0 = 64 * kb, n0 = 32 * nb;
#pragma unroll 8
    for (int i = 0; i < 32; ++i) { const int kk = 2 * i + (lane >> 5); scr[kk * 33 + (lane & 31)] = W[(size_t)(k0 + kk) * N + n0 + (lane & 31)]; }
    LDS_WAIT(); asm volatile("" ::: "memory");
    const int c = lane & 7;
#pragma unroll
    for (int j = 0; j < 4; ++j) { const int n = (lane >> 3) + 8 * j; const LAS float* s = scr + (8 * c) * 33 + n;
        v4u o; o.x = pk2(s[0 * 33], s[1 * 33]); o.y = pk2(s[2 * 33], s[3 * 33]); o.z = pk2(s[4 * 33], s[5 * 33]); o.w = pk2(s[6 * 33], s[7 * 33]);
        *(v4u*)(WT + (size_t)(n0 + n) * ldk + k0 + 8 * c) = o; }
    LDS_WAIT(); asm volatile("" ::: "memory");
}
__device__ __forceinline__ void p0_weff_item(const float* w_pool, const float* pool_scale, const float* w_out, bf16* Wo_t, int item, int lane) {
    const int g = item >> 6, nb = (item >> 2) & 15, cb = item & 3, n = nb * 64 + lane, c0 = cb * 32;
    float acc[32];
#pragma unroll
    for (int c = 0; c < 32; ++c) acc[c] = 0.f;
    const float* wo = w_out + (size_t)(512 + g * 128) * D + n;
    const float* wp = w_pool + (size_t)(g * 128 + c0) * 128;
    const float* ps = pool_scale + g * 128;
    for (int d = 0; d < 128; ++d) {
        const float wv = wo[(size_t)d * D] * ps[d];
#pragma unroll
        for (int c = 0; c < 32; ++c) acc[c] += wp[c * 128 + d] * wv;
    }
    v4u* dst = (v4u*)(Wo_t + (size_t)n * D + 512 + g * 128 + c0);
#pragma unroll
    for (int j = 0; j < 4; ++j) { v4u o; o.x = pk2(acc[8 * j], acc[8 * j + 1]); o.y = pk2(acc[8 * j + 2], acc[8 * j + 3]); o.z = pk2(acc[8 * j + 4], acc[8 * j + 5]); o.w = pk2(acc[8 * j + 6], acc[8 * j + 7]); dst[j] = o; }
}
__device__ __forceinline__ void p0_mod_item(LAS unsigned char* lds, const float* c, const float* w_ada, const float* b_ada, float* mod, int j, int tid, int wave, int lane) {
    LAS float* cact = (LAS float*)(lds + wave * 16384);
    const int n0 = 64 * j, kbase = 128 * wave;
    for (int idx = lane; idx < 4096; idx += 64) { const int kl = idx & 127, b = idx >> 7; cact[kl * 32 + b] = siluf_(c[(size_t)b * D + kbase + kl]); }
    LDS_WAIT(); asm volatile("" ::: "memory");
    float acc[32];
#pragma unroll
    for (int b = 0; b < 32; ++b) acc[b] = 0.f;
    const float* wp = w_ada + (size_t)kbase * NMOD + n0 + lane;
#pragma unroll 4
    for (int kl = 0; kl < 128; ++kl) {
        const float w = wp[(size_t)kl * NMOD];
#pragma unroll
        for (int b4 = 0; b4 < 8; ++b4) { const f32x4 c4 = *(const LAS f32x4*)(cact + kl * 32 + 4 * b4);
            acc[4 * b4 + 0] += c4.x * w; acc[4 * b4 + 1] += c4.y * w; acc[4 * b4 + 2] += c4.z * w; acc[4 * b4 + 3] += c4.w * w; }
    }
    __syncthreads();
    LAS float* red = (LAS float*)lds;
#pragma unroll
    for (int b = 0; b < 32; ++b) red[(wave * 32 + b) * 64 + lane] = acc[b];
    __syncthreads();
#pragma unroll
    for (int i = 0; i < 4; ++i) { const int o = tid + 512 * i, b = o >> 6, n = o & 63; float s = b_ada[n0 + n];
#pragma unroll
        for (int w = 0; w < 8; ++w) s += red[(w * 32 + b) * 64 + n];
        mod[(size_t)b * NMOD + n0 + n] = s; }
    __syncthreads();
}

__device__ __forceinline__ void norm_mod_rows(const float* src, bf16* dst, const float* nw, const float* mod, int sh_off, int sc_off, int gw, int ngw, int lane) {
    for (int rb = gw; rb < M / 32; rb += ngw) {
        const int b = rb >> 6;
        f32x4 A[4], Bv[4];
#pragma unroll
        for (int j = 0; j < 4; ++j) { const int c = 256 * j + 4 * lane; const f32x4 w = *(const f32x4*)(nw + c), sc = *(const f32x4*)(mod + (size_t)b * NMOD + sc_off + c);
            A[j] = w * (sc + 1.0f); Bv[j] = *(const f32x4*)(mod + (size_t)b * NMOD + sh_off + c); }
        for (int r = 0; r < 32; ++r) {
            const size_t m = (size_t)rb * 32 + r;
            const f32x4* xr = (const f32x4*)(src + m * D) + lane;
            f32x4 v[4]; float s = 0.f;
#pragma unroll
            for (int j = 0; j < 4; ++j) { v[j] = xr[64 * j]; s += (v[j].x * v[j].x + v[j].y * v[j].y) + (v[j].z * v[j].z + v[j].w * v[j].w); }
            const float rstd = 1.0f / sqrtf(wave_sum(s) * (1.0f / D) + EPS);
            v2u* o8 = (v2u*)(dst + m * D) + lane;
#pragma unroll
            for (int j = 0; j < 4; ++j) { const f32x4 y = v[j] * rstd * A[j] + Bv[j]; v2u o; o.x = pk2(y.x, y.y); o.y = pk2(y.z, y.w); o8[64 * j] = o; }
        }
    }
}
__device__ __forceinline__ void norm_final_rows(float* io, const float* nw, int gw, int ngw, int lane) {
    f32x4 A[4];
#pragma unroll
    for (int j = 0; j < 4; ++j) A[j] = *(const f32x4*)(nw + 256 * j + 4 * lane);
    for (int m = gw; m < M; m += ngw) {
        f32x4* xr = (f32x4*)(io + (size_t)m * D) + lane;
        f32x4 v[4]; float s = 0.f;
#pragma unroll
        for (int j = 0; j < 4; ++j) { v[j] = xr[64 * j]; s += (v[j].x * v[j].x + v[j].y * v[j].y) + (v[j].z * v[j].z + v[j].w * v[j].w); }
        const float rstd = 1.0f / sqrtf(wave_sum(s) * (1.0f / D) + EPS);
#pragma unroll
        for (int j = 0; j < 4; ++j) xr[64 * j] = v[j] * rstd * A[j];
    }
}

__device__ __forceinline__ void hgrn_simple_unit(LAS unsigned char* lds, const bf16* proj, bf16* mix, const float* lb_logits, const float* g_norm_w, int unit, int tid, int wave, int lane) {
    const int b = unit >> 2, h = unit & 3;
    LAS float* Fs = (LAS float*)lds;
    LAS float* Ks = Fs + 4096;
    LAS float* Qs = Ks + 4096;
    LAS float* Vs = Qs + 4096;
    LAS float* OP = Vs + 4096;
    const int e = tid & 127, dq = __builtin_amdgcn_readfirstlane(tid >> 7);
    float lbv; { const float l0 = lb_logits[h * 128 + e], l1 = lb_logits[DREC + h * 128 + e]; lbv = 1.0f / (1.0f + __expf(l1 - l0)); }
    const float gw0 = g_norm_w[lane], gw1 = g_norm_w[lane + 64];
    float S[32];
#pragma unroll
    for (int i = 0; i < 32; ++i) S[i] = 0.f;
    for (int t0 = 0; t0 < T; t0 += 32) {
#pragma unroll
        for (int i = 0; i < 8; ++i) { const int idx = tid + 512 * i, t = idx >> 7, d = idx & 127;
            const bf16* row = proj + (size_t)(b * T + t0 + t) * DIN + h * 128 + d;
            const float q = bf2f(row[0]), fl = bf2f(row[512]), v = bf2f(row[1024]);
            const float f = lbv + (1.0f - lbv) * sigmoidf_(fl);
            Fs[idx] = f; Ks[idx] = 1.0f - f; Qs[idx] = siluf_(q) * 0.08838834764831845f; Vs[idx] = v; }
        __syncthreads();
        for (int t = 0; t < 32; ++t) {
            const float v = Vs[t * 128 + e]; float op = 0.f;
#pragma unroll
            for (int j = 0; j < 8; ++j) {
                const f32x4 f4 = *(const LAS f32x4*)(Fs + t * 128 + 32 * dq + 4 * j), k4 = *(const LAS f32x4*)(Ks + t * 128 + 32 * dq + 4 * j), q4 = *(const LAS f32x4*)(Qs + t * 128 + 32 * dq + 4 * j);
                S[4 * j + 0] = f4.x * S[4 * j + 0] + k4.x * v; op += S[4 * j + 0] * q4.x;
                S[4 * j + 1] = f4.y * S[4 * j + 1] + k4.y * v; op += S[4 * j + 1] * q4.y;
                S[4 * j + 2] = f4.z * S[4 * j + 2] + k4.z * v; op += S[4 * j + 2] * q4.z;
                S[4 * j + 3] = f4.w * S[4 * j + 3] + k4.w * v; op += S[4 * j + 3] * q4.w;
            }
            OP[(t * 4 + dq) * 128 + e] = op;
        }
        __syncthreads();
#pragma unroll
        for (int i = 0; i < 4; ++i) { const int t = 4 * wave + i;
            float o0 = 0.f, o1 = 0.f;
#pragma unroll
            for (int q = 0; q < 4; ++q) { o0 += OP[(t * 4 + q) * 128 + lane]; o1 += OP[(t * 4 + q) * 128 + lane + 64]; }
            const float rstd = 1.0f / sqrtf(wave_sum(o0 * o0 + o1 * o1) * (1.0f / DH) + EPS);
            const size_t m = (size_t)(b * T + t0 + t);
            const float g0 = bf2f(proj[m * DIN + 1536 + h * 128 + lane]), g1 = bf2f(proj[m * DIN + 1536 + h * 128 + lane + 64]);
            mix[m * D + h * 128 + lane] = (bf16)f2bf(o0 * rstd * gw0 * siluf_(g0));
            mix[m * D + h * 128 + lane + 64] = (bf16)f2bf(o1 * rstd * gw1 * siluf_(g1)); }
        __syncthreads();
    }
}
__device__ __forceinline__ void pool_items(const bf16* proj, bf16* mix, int blk, int nblk, int tid) {
    for (size_t idx = (size_t)blk * NTHREADS + tid; idx < (size_t)M * 64; idx += (size_t)nblk * NTHREADS) {
        const size_t m = idx >> 6; const int c = (int)(idx & 63) * 8, gi = c >> 7, w = 2 << gi, t = (int)(m & (T - 1)), cnt = (t + 1 < w) ? t + 1 : w;
        float acc[8], cur[8];
#pragma unroll
        for (int i = 0; i < 8; ++i) acc[i] = 0.f;
        for (int s = 0; s < cnt; ++s) {
            const v4u p = *(const v4u*)(proj + (m - s) * DIN + 2048 + c);
            const float f0 = bflo(p.x), f1 = bfhi(p.x), f2 = bflo(p.y), f3 = bfhi(p.y), f4 = bflo(p.z), f5 = bfhi(p.z), f6 = bflo(p.w), f7 = bfhi(p.w);
            if (s == 0) { cur[0] = f0; cur[1] = f1; cur[2] = f2; cur[3] = f3; cur[4] = f4; cur[5] = f5; cur[6] = f6; cur[7] = f7; }
            acc[0] += f0; acc[1] += f1; acc[2] += f2; acc[3] += f3; acc[4] += f4; acc[5] += f5; acc[6] += f6; acc[7] += f7;
        }
        const float inv = 1.0f / (float)cnt;
        v4u o; o.x = pk2(acc[0] * inv - cur[0], acc[1] * inv - cur[1]); o.y = pk2(acc[2] * inv - cur[2], acc[3] * inv - cur[3]);
        o.z = pk2(acc[4] * inv - cur[4], acc[5] * inv - cur[5]); o.w = pk2(acc[6] * inv - cur[6], acc[7] * inv - cur[7]);
        *(v4u*)(mix + m * D + 512 + c) = o;
    }
}

struct Args { const float* in[15]; float* out; unsigned char* ws; int ph_lo, ph_hi; };
__global__ void __launch_bounds__(NTHREADS, 2) fwd_megakernel(Args args) {
    extern __shared__ __attribute__((aligned(16))) unsigned char lds_raw[];
    LAS unsigned char* lds = (LAS unsigned char*)lds_raw;
    cg::grid_group grid = cg::this_grid();
    const int tid = threadIdx.x, lane = tid & 63, wave = __builtin_amdgcn_readfirstlane(tid >> 6);
    const int G = gridDim.x, bx = blockIdx.x;
    const int gw = bx * NWAVES + wave, ngw = G * NWAVES;
    const float *x = args.in[0], *c = args.in[1], *w_ada = args.in[2], *b_ada = args.in[3], *norm_mix_w = args.in[4], *w_in = args.in[5], *lb_logits = args.in[6], *g_norm_w = args.in[7],
                *w_pool = args.in[8], *pool_scale = args.in[9], *w_out = args.in[10], *norm_mlp_w = args.in[11], *w_up = args.in[12], *w_down = args.in[13], *norm_final_w = args.in[14];
    unsigned char* ws = args.ws; float* out = args.out;
    bf16 *Win_t = (bf16*)(ws + WS_WIN), *Wo_t = (bf16*)(ws + WS_WO), *Wup_t = (bf16*)(ws + WS_WUP), *Wdn_t = (bf16*)(ws + WS_WDN);
    float* mod = (float*)(ws + WS_MOD);
    bf16 *U = (bf16*)(ws + WS_U), *HID = (bf16*)(ws + WS_HID), *PROJ = (bf16*)(ws + WS_PROJ), *MIX = (bf16*)(ws + WS_MIX);
    const int lo = args.ph_lo, hi = args.ph_hi;
#define IN(k) (lo <= (k) && (k) < hi)
#define SEAM(k) do { if (IN(k) && IN((k) + 1)) grid.sync(); } while (0)

    if (IN(0)) {
        LAS float* scr = (LAS float*)(lds + wave * 16384);
        constexpr int I_IN = (D / 64) * (DIN / 32), I_O = (DREC / 64) * (D / 32), I_UP = (D / 64) * (FF / 32), I_DN = (FF / 64) * (D / 32), I_EFF = 256;
        constexpr int NITEMS = I_IN + I_O + I_UP + I_DN + I_EFF;
        for (int it0 = gw; it0 < NITEMS; it0 += ngw) {
            int r = __builtin_amdgcn_readfirstlane(it0);
            if (r < I_IN) { p0_transpose_item(w_in, DIN, Win_t, D, scr, r, lane); continue; } r -= I_IN;
            if (r < I_O) { p0_transpose_item(w_out, D, Wo_t, D, scr, r, lane); continue; } r -= I_O;
            if (r < I_UP) { p0_transpose_item(w_up, FF, Wup_t, D, scr, r, lane); continue; } r -= I_UP;
            if (r < I_DN) { p0_transpose_item(w_down, D, Wdn_t, FF, scr, r, lane); continue; } r -= I_DN;
            p0_weff_item(w_pool, pool_scale, w_out, Wo_t, r, lane);
        }
        __syncthreads();
        for (int j = G - 1 - bx; j < NMOD / 64; j += G) p0_mod_item(lds, c, w_ada, b_ada, mod, j, tid, wave, lane);
    }
    SEAM(0);
    if (IN(1)) norm_mod_rows(x, U, norm_mix_w, mod, 0, D, gw, ngw, lane);
    SEAM(1);
    if (IN(2)) {
        pg8::Gemm g{U, Win_t, M, DIN, D}; pg8::StaticOrder S; S.init(M, DIN, G, bx);
        pg8::EpiBf16<0> E{PROJ, DIN, nullptr, 0, 0, 1.f};
        pg8::gemm_phase<pg8::EpiBf16<0>, pg8::StaticOrder, true, true>(lds, g, S, E);
    }
    SEAM(2);
    if (IN(3)) {
        const int nh = (G >= 256) ? 128 : G;
        if (bx < nh) for (int u = bx; u < BATCH * NH; u += nh) hgrn_simple_unit(lds, PROJ, MIX, lb_logits, g_norm_w, u, tid, wave, lane);
        if (G >= 256) { if (bx >= 128) pool_items(PROJ, MIX, bx - 128, G - 128, tid); }
        else pool_items(PROJ, MIX, bx, G, tid);
    }
    SEAM(3);
    if (IN(4)) {
        pg8::Gemm g{MIX, Wo_t, M, D, D}; pg8::StaticOrder S; S.init(M, D, G, bx);
        pg8::EpiResGate E{x, out, mod + 2 * D, D, NMOD, T / 256};
        pg8::gemm_phase<pg8::EpiResGate, pg8::StaticOrder, true, true>(lds, g, S, E);
    }
    SEAM(4);
    if (IN(5)) norm_mod_rows(out, U, norm_mlp_w, mod, 3 * D, 4 * D, gw, ngw, lane);
    SEAM(5);
    if (IN(6)) {
        pg8::Gemm g{U, Wup_t, M, FF, D}; pg8::StaticOrder S; S.init(M, FF, G, bx);
        pg8::EpiBf16<2> E{HID, FF, nullptr, 0, 0, 1.f};
        pg8::gemm_phase<pg8::EpiBf16<2>, pg8::StaticOrder, true, true>(lds, g, S, E);
    }
    SEAM(6);
    if (IN(7)) {
        pg8::Gemm g{HID, Wdn_t, M, D, FF}; pg8::StaticOrder S; S.init(M, D, G, bx);
        pg8::EpiResGate E{out, out, mod + 5 * D, D, NMOD, T / 256};
        pg8::gemm_phase<pg8::EpiResGate, pg8::StaticOrder, true, true>(lds, g, S, E);
    }
    SEAM(7);
    if (IN(8)) norm_final_rows(out, norm_final_w, gw, ngw, lane);
#undef IN
#undef SEAM
}

extern "C" void kernel_launch(void* const* d_in, const int* in_sizes, int n_in, void* d_out, int out_size, void* d_ws, size_t ws_size, hipStream_t stream) {
    static int grid = 0;
    if (grid == 0) {
        if (n_in != 15 || in_sizes[0] != M * D || out_size != M * D || ws_size < WS_END) { fprintf(stderr, "kernel_launch: unexpected shapes (n_in %d, in0 %d, out %d, ws %zu)\n", n_in, n_in > 0 ? in_sizes[0] : -1, out_size, ws_size); grid = -1; return; }
        int dev = 0, cus = 0, per_cu = 0;
        (void)hipGetDevice(&dev);
        (void)hipDeviceGetAttribute(&cus, hipDeviceAttributeMultiprocessorCount, dev);
        if (hipFuncSetAttribute((const void*)fwd_megakernel, hipFuncAttributeMaxDynamicSharedMemorySize, LDS_BYTES) != hipSuccess) fprintf(stderr, "kernel_launch: hipFuncSetAttribute failed\n");
        if (hipOccupancyMaxActiveBlocksPerMultiprocessor(&per_cu, (const void*)fwd_megakernel, NTHREADS, LDS_BYTES) != hipSuccess || per_cu < 1) { fprintf(stderr, "kernel_launch: occupancy query says %d\n", per_cu); per_cu = 1; }
        (void)hipGetLastError();
        if (per_cu > 1) per_cu = 1;
        grid = cus * per_cu;
        if (grid <= 0) grid = 256;
    }
    if (grid < 0) return;
    Args a{};
    for (int i = 0; i < 15; ++i) a.in[i] = (const float*)d_in[i];
    a.out = (float*)d_out; a.ws = (unsigned char*)d_ws;
#if MK_N_LAUNCHES == 1
    a.ph_lo = 0; a.ph_hi = N_PHASES;
    void* kargs[] = {&a};
    hipError_t e = hipLaunchCooperativeKernel((const void*)fwd_megakernel, dim3(grid), dim3(NTHREADS), kargs, LDS_BYTES, stream);
    if (e != hipSuccess) fprintf(stderr, "kernel_launch: cooperative launch failed: %s (grid %d)\n", hipGetErrorString(e), grid);
#else
    for (int p = 0; p < N_PHASES; ++p) { a.ph_lo = p; a.ph_hi = p + 1; hipLaunchKernelGGL(fwd_megakernel, dim3(grid), dim3(NTHREADS), LDS_BYTES, stream, a); }
#endif
}
```

```cpp
#include <hip/hip_runtime.h>
#include <hip/hip_cooperative_groups.h>
#include <cstdio>
#include <cstdint>
namespace cg = cooperative_groups;
namespace pg8 {
#define PG8_LAS __attribute__((address_space(3)))
typedef unsigned short bf16_t;
typedef short bf16x8 __attribute__((ext_vector_type(8)));
typedef float f32x4 __attribute__((ext_vector_type(4)));
typedef unsigned u32x4 __attribute__((ext_vector_type(4)));
constexpr int BM = 256, BK = 64, HALF = 128, HTB = HALF * BK * 2  , STAGE_BYTES = 8 * HTB, NXCD = 8, WGM = 8;

__host__ __device__ __forceinline__ int lds_byte(int r, int c) { const int st = (r >> 4) * 2 + (c >> 5), rr = r & 15, cc = c & 31, ob = rr * 64 + cc * 2; return st * 1024 + (ob ^ (((ob >> 9) & 1) << 5)); }
__host__ __device__ __forceinline__ void stage_rc(int b, int& R, int& C) { const int st = b / 1024, sb = b % 1024, swz = sb ^ (((sb >> 9) & 1) << 5); R = (st >> 1) * 16 + swz / 64; C = (st & 1) * 32 + (swz % 64) / 2; }
__host__ __device__ __forceinline__ int perm32(int rho) { const int n = rho >> 4, i = rho & 15; return 8 * (i >> 2) + 4 * n + (i & 3); }

struct Unit { int pm, pn; };
struct Gemm { const bf16_t* A; const bf16_t* Bt; int M, N, K; };

struct StaticOrder {
    int nM, nN, nwg, G, c;
    __host__ __device__ void init(int M, int N, int G_, int c_) { nM = M / BM; nN = N / BM; nwg = nM * nN; G = G_; c = c_; }
    __host__ __device__ bool next(int i, Unit& u) const {
        const long L = (long)i * G + c; if (L >= nwg) return false;
        int wgid = (int)L; { const int q = nwg / NXCD, r = nwg % NXCD, xcd = wgid % NXCD, off = wgid / NXCD; wgid = (xcd < r ? xcd * (q + 1) : r * (q + 1) + (xcd - r) * q) + off; }
        const int nig = WGM * nN, gid = wgid / nig, fm = gid * WGM, gsz = (nM - fm) < WGM ? (nM - fm) : WGM;
        u.pm = fm + ((wgid % nig) % gsz); u.pn = (wgid % nig) / gsz; return true;
    }
    __device__ __forceinline__ void a_ready(const Unit&) const {}
    __device__ __forceinline__ void done(const Unit&) const {}
};

__device__ __forceinline__ unsigned cvt_pk_bf16(float lo, float hi) { unsigned r; asm volatile("v_cvt_pk_bf16_f32 %0, %1, %2" : "=v"(r) : "v"(lo), "v"(hi)); return r; }
typedef float f32x2 __attribute__((ext_vector_type(2)));
__device__ __forceinline__ f32x2 gelu_pk(f32x2 v) {
    const f32x2 av = __builtin_elementwise_abs(v), d = av * 0.2316418882f + 1.0f;
    f32x2 t; t.x = __builtin_amdgcn_rcpf(d.x); t.y = __builtin_amdgcn_rcpf(d.y);
    f32x2 q = t * 0.5307027145f + (-0.7265760135f); q = q * t + 0.7107068705f; q = q * t + (-0.142248368f); q = q * t + 0.127414796f; q = q * t;
    const f32x2 s = (v * v) * (-0.72134752044f);
    f32x2 e; e.x = __builtin_amdgcn_exp2f(s.x); e.y = __builtin_amdgcn_exp2f(s.y);
    const f32x2 m = v * (q * e), r = v - m;
    f32x2 o; o.x = v.x < 0.f ? m.x : r.x; o.y = v.y < 0.f ? m.y : r.y; return o;
}

template <int ACT  > struct EpiBf16 {
    static constexpr bool PERM = true, AFTER_DRAIN = false; static_assert(ACT == 0 || ACT == 1 || ACT == 2, "EpiBf16: ACT is 0 (none), 1 (gelu_pk) or 2 (relu^2)");
    bf16_t* O; int ldc; const float* bias; int split_cols; size_t split_stride; float scale0;
    __device__ __forceinline__ void operator()(const f32x4 (&acc)[2][2][4][2], const Unit& u, int wr, int wc, int fr, int fq) const {
        const int row0 = u.pm * BM + wr * 64 + fr; int colt = u.pn * BM; bf16_t* base = O;
        float sc = 1.f; if (split_cols) { const int t = colt / split_cols; base += (size_t)t * split_stride; colt -= t * split_cols; if (t == 0) sc = scale0; }
        const int col0 = colt + wc * 32 + 8 * fq, bcol0 = u.pn * BM + wc * 32 + 8 * fq;
        f32x4 bv[2][2];
#pragma unroll
        for (int bj = 0; bj < 2; ++bj)
#pragma unroll
            for (int n = 0; n < 2; ++n) bv[bj][n] = bias ? *(const f32x4*)(bias + bcol0 + bj * HALF + 4 * n) : (f32x4){0.f, 0.f, 0.f, 0.f};
#pragma unroll
        for (int ai = 0; ai < 2; ++ai)
#pragma unroll
            for (int m = 0; m < 4; ++m) { bf16_t* rowp = base + (size_t)(row0 + ai * HALF + m * 16) * ldc + col0;
#pragma unroll
                for (int bj = 0; bj < 2; ++bj) { f32x4 v0 = acc[ai][bj][m][0] + bv[bj][0], v1 = acc[ai][bj][m][1] + bv[bj][1];
                    if (ACT == 1) { f32x2 a = gelu_pk((f32x2){v0[0], v0[1]}), b = gelu_pk((f32x2){v0[2], v0[3]}), c = gelu_pk((f32x2){v1[0], v1[1]}), d = gelu_pk((f32x2){v1[2], v1[3]});
                        v0 = (f32x4){a.x, a.y, b.x, b.y}; v1 = (f32x4){c.x, c.y, d.x, d.y}; }
                    if (ACT == 2) { v0 = __builtin_elementwise_max(v0, (f32x4){0.f, 0.f, 0.f, 0.f}); v1 = __builtin_elementwise_max(v1, (f32x4){0.f, 0.f, 0.f, 0.f}); v0 = v0 * v0; v1 = v1 * v1; }
                    v0 = v0 * sc; v1 = v1 * sc; u32x4 w; w.x = cvt_pk_bf16(v0[0], v0[1]); w.y = cvt_pk_bf16(v0[2], v0[3]); w.z = cvt_pk_bf16(v1[0], v1[1]); w.w = cvt_pk_bf16(v1[2], v1[3]);
                    *(u32x4*)(rowp + bj * HALF) = w; } }
    }
};
struct EpiResGate {
    static constexpr bool PERM = true, AFTER_DRAIN = false;
    const float* base; float* out; const float* gate; int ldc, gate_ld, tiles_per_batch;
    __device__ __forceinline__ void operator()(const f32x4 (&acc)[2][2][4][2], const Unit& u, int wr, int wc, int fr, int fq) const {
        const int row0 = u.pm * BM + wr * 64 + fr, col0 = u.pn * BM + wc * 32 + 8 * fq;
        const float* gp = gate + (size_t)(u.pm / tiles_per_batch) * gate_ld + col0;
        f32x4 gv[2][2];
#pragma unroll
        for (int bj = 0; bj < 2; ++bj)
#pragma unroll
            for (int n = 0; n < 2; ++n) gv[bj][n] = *(const f32x4*)(gp + bj * HALF + 4 * n);
#pragma unroll
        for (int ai = 0; ai < 2; ++ai)
#pragma unroll
            for (int m = 0; m < 4; ++m) { const size_t off = (size_t)(row0 + ai * HALF + m * 16) * ldc + col0;
#pragma unroll
                for (int bj = 0; bj < 2; ++bj)
#pragma unroll
                    for (int n = 0; n < 2; ++n) { const f32x4 bs = *(const f32x4*)(base + off + bj * HALF + 4 * n);
                        *(f32x4*)(out + off + bj * HALF + 4 * n) = bs + gv[bj][n] * acc[ai][bj][m][n]; }
                if (m & 1) asm volatile("" ::: "memory"); }
    }
};
template <class Epi, class Sched, bool ALIGN_EPI = false, bool SP2 = false>
__device__ __forceinline__ void gemm_phase(PG8_LAS unsigned char* lds, const Gemm g, const Sched& S, const Epi& E) {
    const int tid = threadIdx.x, wid = __builtin_amdgcn_readfirstlane(tid >> 6), lane = tid & 63, wr = wid >> 2, wc = wid & 3, fr = lane & 15, fq = lane >> 4;
    const int K = g.K, nt = K / BK;
    unsigned voffA[2], voffB[2];
#pragma unroll
    for (int i = 0; i < 2; ++i) { int R, C; stage_rc(tid * 16 + i * 8192, R, C); const int Rb = Epi::PERM ? ((R & ~31) + perm32(R & 31)) : R;
        voffA[i] = (unsigned)(R * K + C) * 2u; voffB[i] = (unsigned)(Rb * K + C) * 2u; }
    const size_t kstep = (size_t)(BK * 2);
    const size_t hstep = (size_t)HALF * K * 2;
    const size_t tstep = 2 * hstep;
    const unsigned ldsw = (unsigned)wid * 1024u;
    const int aoff = lds_byte(wr * 64 + fr, fq * 8), boff = lds_byte(wc * 32 + fr, fq * 8);
#define PG8_SA(b, h) (((b) * 2 + (h)) * HTB)
#define PG8_SB(b, h) ((4 + (b) * 2 + (h)) * HTB)
#define PG8_STAGE(bufoff, gbase, voff) do { _Pragma("unroll") for (int _i = 0; _i < 2; ++_i) \
        __builtin_amdgcn_global_load_lds((const unsigned*)((const char*)(gbase) + (voff)[_i]), (PG8_LAS unsigned*)(lds + (bufoff) + ldsw + _i * 8192), 16, 0, 0); } while (0)
#define PG8_LDA(dst, b, h) do { _Pragma("unroll") for (int m = 0; m < 4; ++m) _Pragma("unroll") for (int k = 0; k < 2; ++k) dst[m][k] = *(const PG8_LAS bf16x8*)(lds + PG8_SA(b, h) + aoff + m * 2048 + k * 1024); } while (0)
#define PG8_LDB(dst, b, h) do { _Pragma("unroll") for (int n = 0; n < 2; ++n) _Pragma("unroll") for (int k = 0; k < 2; ++k) dst[n][k] = *(const PG8_LAS bf16x8*)(lds + PG8_SB(b, h) + boff + n * 2048 + k * 1024); } while (0)
#define PG8_MMA(ai, bj, At, Bt) do { __builtin_amdgcn_s_setprio(1); _Pragma("unroll") for (int m = 0; m < 4; ++m) _Pragma("unroll") for (int n = 0; n < 2; ++n) _Pragma("unroll") for (int k = 0; k < 2; ++k) \
        acc[ai][bj][m][n] = __builtin_amdgcn_mfma_f32_16x16x32_bf16(Bt[n][k], At[m][k], acc[ai][bj][m][n], 0, 0, 0); __builtin_amdgcn_s_setprio(0); } while (0)
#define PG8_WAIT_V(n) asm volatile("s_waitcnt vmcnt(" #n ")" ::: "memory")
#define PG8_WAIT_L(n) asm volatile("s_waitcnt lgkmcnt(" #n ")" ::: "memory")
#define PG8_BAR __builtin_amdgcn_s_barrier()
#define PG8_SCHED __builtin_amdgcn_sched_barrier(0)
    Unit cur, nxt; int ui = 0;
    if (!S.next(0, cur)) return;
    f32x4 acc[2][2][4][2];
#pragma unroll
    for (int a = 0; a < 2; ++a)
#pragma unroll
        for (int b = 0; b < 2; ++b)
#pragma unroll
            for (int m = 0; m < 4; ++m)
#pragma unroll
                for (int n = 0; n < 2; ++n) acc[a][b][m][n] = (f32x4){0.f, 0.f, 0.f, 0.f};
    bf16x8 At[4][2], B0[2][2], B1[2][2];
    const char* cA = (const char*)g.A + (size_t)cur.pm * tstep; const char* cB = (const char*)g.Bt + (size_t)cur.pn * tstep;
    S.a_ready(cur);
    if constexpr (SP2) {
        PG8_STAGE(PG8_SB(0, 0), cB, voffB); PG8_STAGE(PG8_SB(0, 1), cB + hstep, voffB); PG8_STAGE(PG8_SA(0, 0), cA, voffA); PG8_STAGE(PG8_SA(0, 1), cA + hstep, voffA);
        if (wr == 1) PG8_BAR;
        PG8_WAIT_V(2); PG8_BAR;
        PG8_STAGE(PG8_SB(1, 0), cB + kstep, voffB); PG8_STAGE(PG8_SA(1, 0), cA + kstep, voffA); PG8_STAGE(PG8_SB(1, 1), cB + hstep + kstep, voffB);
        PG8_WAIT_V(6); PG8_BAR;
    } else {
        PG8_STAGE(PG8_SB(0, 0), cB, voffB); PG8_STAGE(PG8_SA(0, 0), cA, voffA); PG8_STAGE(PG8_SB(0, 1), cB + hstep, voffB); PG8_STAGE(PG8_SA(0, 1), cA + hstep, voffA);
        if (wr == 1) PG8_BAR;
        PG8_WAIT_V(4); PG8_BAR;
        PG8_STAGE(PG8_SB(1, 0), cB + kstep, voffB); PG8_STAGE(PG8_SA(1, 0), cA + kstep, voffA); PG8_STAGE(PG8_SB(1, 1), cB + hstep + kstep, voffB);
        PG8_WAIT_V(6); PG8_BAR;
    }
    for (;;) {
        const bool has_next = S.next(ui + 1, nxt);
        const char* nA = has_next ? (const char*)g.A + (size_t)nxt.pm * tstep : cA; const char* nB = has_next ? (const char*)g.Bt + (size_t)nxt.pn * tstep : cB;
        for (int t = 0; t < nt; t += 2) {
            const bool last = (t == nt - 2);
            const char* a1 = cA + (size_t)(t + 1) * kstep;
            const char* a2 = last ? nA : cA + (size_t)(t + 2) * kstep; const char* b2 = last ? nB : cB + (size_t)(t + 2) * kstep;
            const char* a3 = a2 + kstep; const char* b3 = b2 + kstep;
            if (last && has_next) S.a_ready(nxt);
            if constexpr (SP2) {
            PG8_LDB(B0, 0, 0); PG8_LDB(B1, 0, 1); PG8_SCHED; PG8_LDA(At, 0, 0); PG8_STAGE(PG8_SA(1, 1), a1 + hstep, voffA);
            PG8_WAIT_V(8); PG8_WAIT_L(0); PG8_BAR; PG8_MMA(0, 0, At, B0); PG8_MMA(0, 1, At, B1); PG8_BAR; PG8_SCHED;
            PG8_LDA(At, 0, 1); PG8_STAGE(PG8_SB(0, 0), b2, voffB); PG8_STAGE(PG8_SB(0, 1), b2 + hstep, voffB); PG8_STAGE(PG8_SA(0, 0), a2, voffA);
            PG8_WAIT_V(8); PG8_WAIT_L(0); PG8_BAR; PG8_MMA(1, 0, At, B0); PG8_MMA(1, 1, At, B1); PG8_BAR; PG8_SCHED;
            PG8_LDB(B0, 1, 0); PG8_LDB(B1, 1, 1); PG8_SCHED; PG8_LDA(At, 1, 0); PG8_STAGE(PG8_SA(0, 1), a2 + hstep, voffA);
            PG8_WAIT_V(8); PG8_WAIT_L(0); PG8_BAR; PG8_MMA(0, 0, At, B0); PG8_MMA(0, 1, At, B1); PG8_BAR; PG8_SCHED;
            PG8_LDA(At, 1, 1); PG8_STAGE(PG8_SB(1, 0), b3, voffB); PG8_STAGE(PG8_SB(1, 1), b3 + hstep, voffB); PG8_STAGE(PG8_SA(1, 0), a3, voffA);
            PG8_WAIT_V(8); PG8_WAIT_L(0); PG8_BAR; PG8_MMA(1, 0, At, B0); PG8_MMA(1, 1, At, B1); PG8_BAR; PG8_SCHED;
            } else {
            PG8_LDB(B0, 0, 0); PG8_SCHED; PG8_LDA(At, 0, 0); PG8_STAGE(PG8_SA(1, 1), a1 + hstep, voffA);
            PG8_WAIT_L(8); PG8_BAR; PG8_WAIT_L(0); PG8_MMA(0, 0, At, B0); PG8_BAR; PG8_SCHED;
            PG8_LDB(B1, 0, 1); PG8_STAGE(PG8_SB(0, 0), b2, voffB);
            PG8_BAR; PG8_WAIT_L(0); PG8_MMA(0, 1, At, B1); PG8_BAR;
            PG8_LDA(At, 0, 1); PG8_STAGE(PG8_SA(0, 0), a2, voffA);
            PG8_BAR; PG8_WAIT_L(0); PG8_MMA(1, 0, At, B0); PG8_BAR; PG8_SCHED;
            PG8_STAGE(PG8_SB(0, 1), b2 + hstep, voffB);
            PG8_WAIT_V(6); PG8_BAR; PG8_MMA(1, 1, At, B1); PG8_BAR;
            PG8_LDB(B0, 1, 0); PG8_SCHED; PG8_LDA(At, 1, 0); PG8_STAGE(PG8_SA(0, 1), a2 + hstep, voffA);
            PG8_WAIT_L(8); PG8_BAR; PG8_WAIT_L(0); PG8_MMA(0, 0, At, B0); PG8_BAR; PG8_SCHED;
            PG8_LDB(B1, 1, 1); PG8_STAGE(PG8_SB(1, 0), b3, voffB);
            PG8_BAR; PG8_WAIT_L(0); PG8_MMA(0, 1, At, B1); PG8_BAR;
            PG8_LDA(At, 1, 1); PG8_STAGE(PG8_SA(1, 0), a3, voffA);
            PG8_BAR; PG8_WAIT_L(0); PG8_MMA(1, 0, At, B0); PG8_BAR; PG8_SCHED;
            PG8_STAGE(PG8_SB(1, 1), b3 + hstep, voffB);
            PG8_WAIT_V(6); PG8_BAR; PG8_MMA(1, 1, At, B1); PG8_BAR;
            }
        }
        if constexpr (ALIGN_EPI) { if (wr == 0) PG8_BAR; }
        if constexpr (!Epi::AFTER_DRAIN) { E(acc, cur, wr, wc, fr, fq); S.done(cur); }
        if (!has_next) break;
#pragma unroll
        for (int a = 0; a < 2; ++a)
#pragma unroll
            for (int b = 0; b < 2; ++b)
#pragma unroll
                for (int m = 0; m < 4; ++m)
#pragma unroll
                    for (int n = 0; n < 2; ++n) acc[a][b][m][n] = (f32x4){0.f, 0.f, 0.f, 0.f};
        cur = nxt; cA = nA; cB = nB; ++ui;
        if constexpr (ALIGN_EPI) { if (wr == 1) PG8_BAR; }
    }
    PG8_WAIT_V(0);
    if constexpr (!ALIGN_EPI) { if (wr == 0) PG8_BAR; }
    PG8_BAR;
    if constexpr (Epi::AFTER_DRAIN) { E.fused(acc, cur, wr, wc, fr, fq, lds, wid, lane); S.done(cur); }
#undef PG8_SA
#undef PG8_SB
#undef PG8_STAGE
#undef PG8_LDA
#undef PG8_LDB
#undef PG8_MMA
#undef PG8_WAIT_V
#undef PG8_WAIT_L
#undef PG8_BAR
#undef PG8_SCHED
}
}

constexpr int NWAVES = 8, NTHREADS = NWAVES * 64;
#ifndef MK_N_LAUNCHES
#define MK_N_LAUNCHES 1
#endif
constexpr int N_PHASES = 9;
constexpr int BATCH = 32, T = 2048, D = 1024, M = BATCH * T, DIN = 2560, FF = 4096, DREC = 512, NH = 4, DH = 128, NMOD = 6 * D;
constexpr float EPS = 1e-6f;
constexpr size_t MiB = 1u << 20;
constexpr size_t WS_WIN = 2 * MiB, WS_WO = 8 * MiB, WS_WUP = 10 * MiB, WS_WDN = 18 * MiB, WS_MOD = 26 * MiB, WS_U = 32 * MiB, WS_HID = 160 * MiB, WS_PROJ = 160 * MiB, WS_MIX = 480 * MiB, WS_END = 672 * MiB;
static_assert(WS_PROJ + (size_t)M * DIN * 2 <= WS_MIX && WS_MIX + (size_t)M * D * 2 <= WS_END && WS_HID + (size_t)M * FF * 2 <= WS_END && WS_U + (size_t)M * D * 2 <= WS_HID, "d_ws map");
constexpr int LDS_BYTES = 147456;

#define LAS __attribute__((address_space(3)))
typedef unsigned short bf16;
typedef unsigned v4u __attribute__((ext_vector_type(4)));
typedef unsigned v2u __attribute__((ext_vector_type(2)));
typedef float f32x4 __attribute__((ext_vector_type(4)));
#define LDS_WAIT() asm volatile("s_waitcnt lgkmcnt(0)" ::: "memory")
__device__ __forceinline__ unsigned f2bf(float f) { unsigned u = __builtin_bit_cast(unsigned, f); return (u + 0x7fffu + ((u >> 16) & 1u)) >> 16; }
__device__ __forceinline__ unsigned pk2(float lo, float hi) { return f2bf(lo) | (f2bf(hi) << 16); }
__device__ __forceinline__ float bf2f(unsigned h) { return __builtin_bit_cast(float, h << 16); }
__device__ __forceinline__ float bflo(unsigned w) { return __builtin_bit_cast(float, w << 16); }
__device__ __forceinline__ float bfhi(unsigned w) { return __builtin_bit_cast(float, w & 0xffff0000u); }
__device__ __forceinline__ float sigmoidf_(float x) { return 1.0f / (1.0f + __expf(-x)); }
__device__ __forceinline__ float siluf_(float x) { return x / (1.0f + __expf(-x)); }
__device__ __forceinline__ float wave_sum(float v) {
#pragma unroll
    for (int o = 1; o < 64; o <<= 1) v += __shfl_xor(v, o);
    return v;
}

__device__ __forceinline__ void p0_transpose_item(const float* W, int N, bf16* WT, int ldk, LAS float* scr, int item, int lane) {
    const int nblk = N / 32, kb = item / nblk, nb = item % nblk, k0 = 64 * kb, n0 = 32 * nb;
#pragma unroll 8
    for (int i = 0; i < 32; ++i) { const int kk = 2 * i + (lane >> 5); scr[kk * 33 + (lane & 31)] = W[(size_t)(k0 + kk) * N + n0 + (lane & 31)]; }
    LDS_WAIT(); asm volatile("" ::: "memory");
    const int c = lane & 7;
#pragma unroll
    for (int j = 0; j < 4; ++j) { const int n = (lane >> 3) + 8 * j; const LAS float* s = scr + (8 * c) * 33 + n;
        v4u o; o.x = pk2(s[0 * 33], s[1 * 33]); o.y = pk2(s[2 * 33], s[3 * 33]); o.z = pk2(s[4 * 33], s[5 * 33]); o.w = pk2(s[6 * 33], s[7 * 33]);
        *(v4u*)(WT + (size_t)(n0 + n) * ldk + k0 + 8 * c) = o; }
    LDS_WAIT(); asm volatile("" ::: "memory");
}
__device__ __forceinline__ void p0_weff_item(const float* w_pool, const float* pool_scale, const float* w_out, bf16* Wo_t, int item, int lane) {
    const int g = item >> 6, nb = (item >> 2) & 15, cb = item & 3, n = nb * 64 + lane, c0 = cb * 32;
    float acc[32];
#pragma unroll
    for (int c = 0; c < 32; ++c) acc[c] = 0.f;
    const float* wo = w_out + (size_t)(512 + g * 128) * D + n;
    const float* wp = w_pool + (size_t)(g * 128 + c0) * 128;
    const float* ps = pool_scale + g * 128;
    for (int d = 0; d < 128; ++d) {
        const float wv = wo[(size_t)d * D] * ps[d];
#pragma unroll
        for (int c = 0; c < 32; ++c) acc[c] += wp[c * 128 + d] * wv;
    }
    v4u* dst = (v4u*)(Wo_t + (size_t)n * D + 512 + g * 128 + c0);
#pragma unroll
    for (int j = 0; j < 4; ++j) { v4u o; o.x = pk2(acc[8 * j], acc[8 * j + 1]); o.y = pk2(acc[8 * j + 2], acc[8 * j + 3]); o.z = pk2(acc[8 * j + 4], acc[8 * j + 5]); o.w = pk2(acc[8 * j + 6], acc[8 * j + 7]); dst[j] = o; }
}
__device__ __forceinline__ void p0_mod_item(LAS unsigned char* lds, const float* c, const float* w_ada, const float* b_ada, float* mod, int j, int tid, int wave, int lane) {
    LAS float* cact = (LAS float*)(lds + wave * 16384);
    const int n0 = 64 * j, kbase = 128 * wave;
    for (int idx = lane; idx < 4096; idx += 64) { const int kl = idx & 127, b = idx >> 7; cact[kl * 32 + b] = siluf_(c[(size_t)b * D + kbase + kl]); }
    LDS_WAIT(); asm volatile("" ::: "memory");
    float acc[32];
#pragma unroll
    for (int b = 0; b < 32; ++b) acc[b] = 0.f;
    const float* wp = w_ada + (size_t)kbase * NMOD + n0 + lane;
#pragma unroll 4
    for (int kl = 0; kl < 128; ++kl) {
        const float w = wp[(size_t)kl * NMOD];
#pragma unroll
        for (int b4 = 0; b4 < 8; ++b4) { const f32x4 c4 = *(const LAS f32x4*)(cact + kl * 32 + 4 * b4);
            acc[4 * b4 + 0] += c4.x * w; acc[4 * b4 + 1] += c4.y * w; acc[4 * b4 + 2] += c4.z * w; acc[4 * b4 + 3] += c4.w * w; }
    }
    __syncthreads();
    LAS float* red = (LAS float*)lds;
#pragma unroll
    for (int b = 0; b < 32; ++b) red[(wave * 32 + b) * 64 + lane] = acc[b];
    __syncthreads();
#pragma unroll
    for (int i = 0; i < 4; ++i) { const int o = tid + 512 * i, b = o >> 6, n = o & 63; float s = b_ada[n0 + n];
#pragma unroll
        for (int w = 0; w < 8; ++w) s += red[(w * 32 + b) * 64 + n];
        mod[(size_t)b * NMOD + n0 + n] = s; }
    __syncthreads();
}

__device__ __forceinline__ void norm_mod_rows(const float* src, bf16* dst, const float* nw, const float* mod, int sh_off, int sc_off, int gw, int ngw, int lane) {
    for (int rb = gw; rb < M / 32; rb += ngw) {
        const int b = rb >> 6;
        f32x4 A[4], Bv[4];
#pragma unroll
        for (int j = 0; j < 4; ++j) { const int c = 256 * j + 4 * lane; const f32x4 w = *(const f32x4*)(nw + c), sc = *(const f32x4*)(mod + (size_t)b * NMOD + sc_off + c);
            A[j] = w * (sc + 1.0f); Bv[j] = *(const f32x4*)(mod + (size_t)b * NMOD + sh_off + c); }
        for (int r = 0; r < 32; ++r) {
            const size_t m = (size_t)rb * 32 + r;
            const f32x4* xr = (const f32x4*)(src + m * D) + lane;
            f32x4 v[4]; float s = 0.f;
#pragma unroll
            for (int j = 0; j < 4; ++j) { v[j] = xr[64 * j]; s += (v[j].x * v[j].x + v[j].y * v[j].y) + (v[j].z * v[j].z + v[j].w * v[j].w); }
            const float rstd = 1.0f / sqrtf(wave_sum(s) * (1.0f / D) + EPS);
            v2u* o8 = (v2u*)(dst + m * D) + lane;
#pragma unroll
            for (int j = 0; j < 4; ++j) { const f32x4 y = v[j] * rstd * A[j] + Bv[j]; v2u o; o.x = pk2(y.x, y.y); o.y = pk2(y.z, y.w); o8[64 * j] = o; }
        }
    }
}
__device__ __forceinline__ void norm_final_rows(float* io, const float* nw, int gw, int ngw, int lane) {
    f32x4 A[4];
#pragma unroll
    for (int j = 0; j < 4; ++j) A[j] = *(const f32x4*)(nw + 256 * j + 4 * lane);
    for (int m = gw; m < M; m += ngw) {
        f32x4* xr = (f32x4*)(io + (size_t)m * D) + lane;
        f32x4 v[4]; float s = 0.f;
#pragma unroll
        for (int j = 0; j < 4; ++j) { v[j] = xr[64 * j]; s += (v[j].x * v[j].x + v[j].y * v[j].y) + (v[j].z * v[j].z + v[j].w * v[j].w); }
        const float rstd = 1.0f / sqrtf(wave_sum(s) * (1.0f / D) + EPS);
#pragma unroll
        for (int j = 0; j < 4; ++j) xr[64 * j] = v[j] * rstd * A[j];
    }
}

__device__ __forceinline__ void hgrn_simple_unit(LAS unsigned char* lds, const bf16* proj, bf16* mix, const float* lb_logits, const float* g_norm_w, int unit, int tid, int wave, int lane) {
    const int b = unit >> 2, h = unit & 3;
    LAS float* Fs = (LAS float*)lds;
    LAS float* Ks = Fs + 4096;
    LAS float* Qs = Ks + 4096;
    LAS float* Vs = Qs + 4096;
    LAS float* OP = Vs + 4096;
    const int e = tid & 127, dq = __builtin_amdgcn_readfirstlane(tid >> 7);
    float lbv; { const float l0 = lb_logits[h * 128 + e], l1 = lb_logits[DREC + h * 128 + e]; lbv = 1.0f / (1.0f + __expf(l1 - l0)); }
    const float gw0 = g_norm_w[lane], gw1 = g_norm_w[lane + 64];
    float S[32];
#pragma unroll
    for (int i = 0; i < 32; ++i) S[i] = 0.f;
    for (int t0 = 0; t0 < T; t0 += 32) {
#pragma unroll
        for (int i = 0; i < 8; ++i) { const int idx = tid + 512 * i, t = idx >> 7, d = idx & 127;
            const bf16* row = proj + (size_t)(b * T + t0 + t) * DIN + h * 128 + d;
            const float q = bf2f(row[0]), fl = bf2f(row[512]), v = bf2f(row[1024]);
            const float f = lbv + (1.0f - lbv) * sigmoidf_(fl);
            Fs[idx] = f; Ks[idx] = 1.0f - f; Qs[idx] = siluf_(q) * 0.08838834764831845f; Vs[idx] = v; }
        __syncthreads();
        for (int t = 0; t < 32; ++t) {
            const float v = Vs[t * 128 + e]; float op = 0.f;
#pragma unroll
            for (int j = 0; j < 8; ++j) {
                const f32x4 f4 = *(const LAS f32x4*)(Fs + t * 128 + 32 * dq + 4 * j), k4 = *(const LAS f32x4*)(Ks + t * 128 + 32 * dq + 4 * j), q4 = *(const LAS f32x4*)(Qs + t * 128 + 32 * dq + 4 * j);
                S[4 * j + 0] = f4.x * S[4 * j + 0] + k4.x * v; op += S[4 * j + 0] * q4.x;
                S[4 * j + 1] = f4.y * S[4 * j + 1] + k4.y * v; op += S[4 * j + 1] * q4.y;
                S[4 * j + 2] = f4.z * S[4 * j + 2] + k4.z * v; op += S[4 * j + 2] * q4.z;
                S[4 * j + 3] = f4.w * S[4 * j + 3] + k4.w * v; op += S[4 * j + 3] * q4.w;
            }
            OP[(t * 4 + dq) * 128 + e] = op;
        }
        __syncthreads();
#pragma unroll
        for (int i = 0; i < 4; ++i) { const int t = 4 * wave + i;
            float o0 = 0.f, o1 = 0.f;
#pragma unroll
            for (int q = 0; q < 4; ++q) { o0 += OP[(t * 4 + q) * 128 + lane]; o1 += OP[(t * 4 + q) * 128 + lane + 64]; }
            const float rstd = 1.0f / sqrtf(wave_sum(o0 * o0 + o1 * o1) * (1.0f / DH) + EPS);
            const size_t m = (size_t)(b * T + t0 + t);
            const float g0 = bf2f(proj[m * DIN + 1536 + h * 128 + lane]), g1 = bf2f(proj[m * DIN + 1536 + h * 128 + lane + 64]);
            mix[m * D + h * 128 + lane] = (bf16)f2bf(o0 * rstd * gw0 * siluf_(g0));
            mix[m * D + h * 128 + lane + 64] = (bf16)f2bf(o1 * rstd * gw1 * siluf_(g1)); }
        __syncthreads();
    }
}
typedef short s16x4 __attribute__((ext_vector_type(4)));
typedef __bf16 bf16x2_t __attribute__((ext_vector_type(2)));
typedef float f32x2_t __attribute__((ext_vector_type(2)));
__device__ __forceinline__ unsigned cvtpk(float lo, float hi) { f32x2_t v = {lo, hi}; return __builtin_bit_cast(unsigned, __builtin_convertvector(v, bf16x2_t)); }
#define MFMA16(a, b, c) __builtin_amdgcn_mfma_f32_16x16x32_bf16((a), (b), (c), 0, 0, 0)
constexpr int HG_QD = 0, HG_KD = 8704, HG_KDT = 17408, HG_VT = 27648, HG_CN = 37888, HG_EB = 38400, HG_P = 2 * HG_EB, HG_SSP = HG_P + 2560, HG_BYTES = HG_SSP + 1024;
#define HG_BAR() do { asm volatile("s_waitcnt lgkmcnt(0)" ::: "memory"); __builtin_amdgcn_s_barrier(); asm volatile("" ::: "memory"); } while (0)
#define HG_LOADE(t0_) do { _Pragma("unroll") for (int i = 0; i < 8; ++i) { const bf16* row_ = pbase + (size_t)((t0_) + 8 * g4 + i) * DIN; rq[i] = row_[0]; rf[i] = row_[512]; rv[i] = row_[1024]; } } while (0)
#define HG_LOADG(t0_) do { _Pragma("unroll") for (int i = 0; i < 8; ++i) rg[i] = pbase[(size_t)((t0_) + 16 * (i >> 2) + 4 * g4 + (i & 3)) * DIN + 1536]; } while (0)
#define HG_EPHASE(eb_) do { \
        float kk[8], bl[8]; float run = 0.f; \
        _Pragma("unroll") for (int i = 0; i < 8; ++i) { const float fl = bf2f(rf[i]); const float f = lbv + oml * __builtin_amdgcn_rcpf(1.0f + __builtin_amdgcn_exp2f(-fl * LOG2E)); \
            kk[i] = 1.0f - f; run += __builtin_amdgcn_logf(f); bl[i] = run; } \
        const float t0s = __shfl(run, m16), t1s = __shfl(run, m16 + 16), t2s = __shfl(run, m16 + 32), t3s = __shfl(run, m16 + 48); \
        const float bref = t0s + t1s; \
        const float pre = (g4 > 0 ? t0s : 0.f) + (g4 > 1 ? t1s : 0.f) + (g4 > 2 ? t2s : 0.f) - bref; \
        v4u kt; unsigned ktw[4]; \
        _Pragma("unroll") for (int i = 0; i < 8; i += 2) { \
            const float bb0 = bl[i] + pre, bb1 = bl[i + 1] + pre; \
            const float q0 = bf2f(rq[i]), q1 = bf2f(rq[i + 1]); \
            const float qd0 = q0 * __builtin_amdgcn_rcpf(1.0f + __builtin_amdgcn_exp2f(-q0 * LOG2E)) * QSCALE * __builtin_amdgcn_exp2f(bb0); \
            const float qd1 = q1 * __builtin_amdgcn_rcpf(1.0f + __builtin_amdgcn_exp2f(-q1 * LOG2E)) * QSCALE * __builtin_amdgcn_exp2f(bb1); \
            const float kd0 = kk[i] * __builtin_amdgcn_exp2f(-bb0), kd1 = kk[i + 1] * __builtin_amdgcn_exp2f(-bb1); \
            const unsigned qw = cvtpk(qd0, qd1), kw = cvtpk(kd0, kd1); ktw[i >> 1] = kw; \
            *(LAS unsigned short*)((eb_) + HG_QD + (8 * g4 + i) * 272 + d * 2) = (unsigned short)(qw & 0xffffu); \
            *(LAS unsigned short*)((eb_) + HG_QD + (8 * g4 + i + 1) * 272 + d * 2) = (unsigned short)(qw >> 16); \
            *(LAS unsigned short*)((eb_) + HG_KD + (8 * g4 + i) * 272 + d * 2) = (unsigned short)(kw & 0xffffu); \
            *(LAS unsigned short*)((eb_) + HG_KD + (8 * g4 + i + 1) * 272 + d * 2) = (unsigned short)(kw >> 16); } \
        kt.x = ktw[0]; kt.y = ktw[1]; kt.z = ktw[2]; kt.w = ktw[3]; \
        *(LAS v4u*)((eb_) + HG_KDT + d * 80 + 16 * g4) = kt; \
        { v4u vt; vt.x = (unsigned)rv[0] | ((unsigned)rv[1] << 16); vt.y = (unsigned)rv[2] | ((unsigned)rv[3] << 16); vt.z = (unsigned)rv[4] | ((unsigned)rv[5] << 16); vt.w = (unsigned)rv[6] | ((unsigned)rv[7] << 16); \
          *(LAS v4u*)((eb_) + HG_VT + d * 80 + 16 * g4) = vt; } \
        if (g4 == 0) *(LAS float*)((eb_) + HG_CN + d * 4) = __builtin_amdgcn_exp2f(bref + carry); \
        carry = t2s + t3s; } while (0)

__device__ __forceinline__ void hgrn_mfma_unit(LAS unsigned char* lds, const bf16* proj, bf16* mix, const float* lb_logits, const float* g_norm_w, int unit, int wave, int lane) {
    using pg8::bf16x8;
    constexpr float LOG2E = 1.4426950408889634f, QSCALE = 0.08838834764831845f;
    const int b = unit >> 2, h = unit & 3, m16 = lane & 15, g4 = lane >> 4, d = 16 * wave + m16;
    float lbv; { const float l0 = lb_logits[h * 128 + d], l1 = lb_logits[DREC + h * 128 + d]; lbv = 1.0f / (1.0f + __expf(l1 - l0)); }
    const float oml = 1.0f - lbv, gwv = g_norm_w[d];
    const bf16* pbase = proj + (size_t)b * T * DIN + h * 128 + d;
    bf16* obase = mix + (size_t)b * T * D + h * 128 + d;
    LAS unsigned char* P = lds + HG_P; LAS float* SSP = (LAS float*)(lds + HG_SSP);
    if (wave == 3) *(LAS v2u*)(P + m16 * 80 + 32 + 8 * g4) = (v2u){0u, 0u};
    unsigned short rq[8], rf[8], rv[8], rg[8];
    f32x4 Sacc[8]; bf16x8 Sb[4];
#pragma unroll
    for (int i = 0; i < 8; ++i) Sacc[i] = (f32x4){0.f, 0.f, 0.f, 0.f};
#pragma unroll
    for (int i = 0; i < 4; ++i) Sb[i] = (bf16x8){0, 0, 0, 0, 0, 0, 0, 0};
    float carry = 0.f;
    HG_LOADE(0); HG_EPHASE(lds); HG_LOADE(32); HG_LOADG(0);
    HG_BAR();
    for (int n = 0; n < T / 32; ++n) {
        LAS unsigned char* eb = lds + (n & 1) * HG_EB; LAS unsigned char* en = lds + ((n + 1) & 1) * HG_EB;
        if (wave < 3) {
            const int mt = wave > 0, nt = wave > 1; f32x4 acc = (f32x4){0.f, 0.f, 0.f, 0.f};
#pragma unroll
            for (int ks = 0; ks < 4; ++ks) { const bf16x8 A = *(const LAS bf16x8*)(eb + HG_QD + (16 * mt + m16) * 272 + (32 * ks + 8 * g4) * 2), B = *(const LAS bf16x8*)(eb + HG_KD + (16 * nt + m16) * 272 + (32 * ks + 8 * g4) * 2);
                acc = MFMA16(A, B, acc); }
#pragma unroll
            for (int i = 0; i < 4; ++i) { const int t = 16 * mt + 4 * g4 + i, s = 16 * nt + m16; const float val = (s <= t) ? acc[i] : 0.f;
                *(LAS unsigned short*)(P + t * 80 + s * 2) = (unsigned short)f2bf(val); }
        }
        if (n + 1 < T / 32) { HG_EPHASE(en); if (n + 2 < T / 32) HG_LOADE((n + 2) * 32); }
        HG_BAR();
        const bf16x8 vfrag = *(const LAS bf16x8*)(eb + HG_VT + d * 80 + 16 * g4);
        f32x4 o[2];
#pragma unroll
        for (int mt = 0; mt < 2; ++mt) { f32x4 acc = (f32x4){0.f, 0.f, 0.f, 0.f};
#pragma unroll
            for (int ks = 0; ks < 4; ++ks) { const s16x4 lo = *(const LAS s16x4*)(eb + HG_QD + (16 * mt + m16) * 272 + (32 * ks + 4 * g4) * 2), hi = *(const LAS s16x4*)(eb + HG_QD + (16 * mt + m16) * 272 + (32 * ks + 16 + 4 * g4) * 2);
                acc = MFMA16(__builtin_shufflevector(lo, hi, 0, 1, 2, 3, 4, 5, 6, 7), Sb[ks], acc); }
            const bf16x8 Pa = *(const LAS bf16x8*)(P + (16 * mt + m16) * 80 + 16 * g4);
            o[mt] = MFMA16(Pa, vfrag, acc); }
        if (n + 1 < T / 32) {
#pragma unroll
            for (int mt8 = 0; mt8 < 8; ++mt8) { const bf16x8 A = *(const LAS bf16x8*)(eb + HG_KDT + (16 * mt8 + m16) * 80 + 16 * g4);
                Sacc[mt8] = MFMA16(A, vfrag, Sacc[mt8]);
                const f32x4 cn4 = *(const LAS f32x4*)(en + HG_CN + (16 * mt8 + 4 * g4) * 4); Sacc[mt8] = Sacc[mt8] * cn4; }
#pragma unroll
            for (int ks = 0; ks < 4; ++ks) { v4u w; w.x = cvtpk(Sacc[2 * ks][0], Sacc[2 * ks][1]); w.y = cvtpk(Sacc[2 * ks][2], Sacc[2 * ks][3]); w.z = cvtpk(Sacc[2 * ks + 1][0], Sacc[2 * ks + 1][1]); w.w = cvtpk(Sacc[2 * ks + 1][2], Sacc[2 * ks + 1][3]);
                Sb[ks] = __builtin_bit_cast(bf16x8, w); }
        }
#pragma unroll
        for (int i = 0; i < 8; ++i) { float sq = o[i >> 2][i & 3] * o[i >> 2][i & 3];
            sq += __shfl_xor(sq, 1); sq += __shfl_xor(sq, 2); sq += __shfl_xor(sq, 4); sq += __shfl_xor(sq, 8);
            if (m16 == 0) SSP[(16 * (i >> 2) + 4 * g4 + (i & 3)) * 8 + wave] = sq; }
        HG_BAR();
#pragma unroll
        for (int i = 0; i < 8; ++i) { const int t = 16 * (i >> 2) + 4 * g4 + (i & 3);
            const f32x4 s0 = *(const LAS f32x4*)(SSP + t * 8), s1 = *(const LAS f32x4*)(SSP + t * 8 + 4);
            const float ss = ((s0.x + s0.y) + (s0.z + s0.w)) + ((s1.x + s1.y) + (s1.z + s1.w));
            const float rstd = 1.0f / sqrtf(ss * (1.0f / DH) + EPS);
            const float gv = bf2f(rg[i]);
            const float val = o[i >> 2][i & 3] * rstd * gwv * gv * __builtin_amdgcn_rcpf(1.0f + __builtin_amdgcn_exp2f(-gv * LOG2E));
            obase[(size_t)(n * 32 + t) * D] = (bf16)f2bf(val); }
        if (n + 1 < T / 32) HG_LOADG((n + 1) * 32);
    }
    HG_BAR();
}
__device__ __forceinline__ void pool_items(const bf16* proj, bf16* mix, int blk, int nblk, int tid) {
    for (size_t idx = (size_t)blk * NTHREADS + tid; idx < (size_t)M * 64; idx += (size_t)nblk * NTHREADS) {
        const size_t m = idx >> 6; const int c = (int)(idx & 63) * 8, gi = c >> 7, w = 2 << gi, t = (int)(m & (T - 1)), cnt = (t + 1 < w) ? t + 1 : w;
        float acc[8], cur[8];
#pragma unroll
        for (int i = 0; i < 8; ++i) acc[i] = 0.f;
        for (int s = 0; s < cnt; ++s) {
            const v4u p = *(const v4u*)(proj + (m - s) * DIN + 2048 + c);
            const float f0 = bflo(p.x), f1 = bfhi(p.x), f2 = bflo(p.y), f3 = bfhi(p.y), f4 = bflo(p.z), f5 = bfhi(p.z), f6 = bflo(p.w), f7 = bfhi(p.w);
            if (s == 0) { cur[0] = f0; cur[1] = f1; cur[2] = f2; cur[3] = f3; cur[4] = f4; cur[5] = f5; cur[6] = f6; cur[7] = f7; }
            acc[0] += f0; acc[1] += f1; acc[2] += f2; acc[3] += f3; acc[4] += f4; acc[5] += f5; acc[6] += f6; acc[7] += f7;
        }
        const float inv = 1.0f / (float)cnt;
        v4u o; o.x = pk2(acc[0] * inv - cur[0], acc[1] * inv - cur[1]); o.y = pk2(acc[2] * inv - cur[2], acc[3] * inv - cur[3]);
        o.z = pk2(acc[4] * inv - cur[4], acc[5] * inv - cur[5]); o.w = pk2(acc[6] * inv - cur[6], acc[7] * inv - cur[7]);
        *(v4u*)(mix + m * D + 512 + c) = o;
    }
}

struct Args { const float* in[15]; float* out; unsigned char* ws; int ph_lo, ph_hi; };
__global__ void __launch_bounds__(NTHREADS, 2) fwd_megakernel(Args args) {
    extern __shared__ __attribute__((aligned(16))) unsigned char lds_raw[];
    LAS unsigned char* lds = (LAS unsigned char*)lds_raw;
    cg::grid_group grid = cg::this_grid();
    const int tid = threadIdx.x, lane = tid & 63, wave = __builtin_amdgcn_readfirstlane(tid >> 6);
    const int G = gridDim.x, bx = blockIdx.x;
    const int gw = bx * NWAVES + wave, ngw = G * NWAVES;
    const float *x = args.in[0], *c = args.in[1], *w_ada = args.in[2], *b_ada = args.in[3], *norm_mix_w = args.in[4], *w_in = args.in[5], *lb_logits = args.in[6], *g_norm_w = args.in[7],
                *w_pool = args.in[8], *pool_scale = args.in[9], *w_out = args.in[10], *norm_mlp_w = args.in[11], *w_up = args.in[12], *w_down = args.in[13], *norm_final_w = args.in[14];
    unsigned char* ws = args.ws; float* out = args.out;
    bf16 *Win_t = (bf16*)(ws + WS_WIN), *Wo_t = (bf16*)(ws + WS_WO), *Wup_t = (bf16*)(ws + WS_WUP), *Wdn_t = (bf16*)(ws + WS_WDN);
    float* mod = (float*)(ws + WS_MOD);
    bf16 *U = (bf16*)(ws + WS_U), *HID = (bf16*)(ws + WS_HID), *PROJ = (bf16*)(ws + WS_PROJ), *MIX = (bf16*)(ws + WS_MIX);
    const int lo = args.ph_lo, hi = args.ph_hi;
#define IN(k) (lo <= (k) && (k) < hi)
#define SEAM(k) do { if (IN(k) && IN((k) + 1)) grid.sync(); } while (0)

    if (IN(0)) {
        LAS float* scr = (LAS float*)(lds + wave * 16384);
        constexpr int I_IN = (D / 64) * (DIN / 32), I_O = (DREC / 64) * (D / 32), I_UP = (D / 64) * (FF / 32), I_DN = (FF / 64) * (D / 32), I_EFF = 256;
        constexpr int NITEMS = I_IN + I_O + I_UP + I_DN + I_EFF;
        for (int it0 = gw; it0 < NITEMS; it0 += ngw) {
            int r = __builtin_amdgcn_readfirstlane(it0);
            if (r < I_IN) { p0_transpose_item(w_in, DIN, Win_t, D, scr, r, lane); continue; } r -= I_IN;
            if (r < I_O) { p0_transpose_item(w_out, D, Wo_t, D, scr, r, lane); continue; } r -= I_O;
            if (r < I_UP) { p0_transpose_item(w_up, FF, Wup_t, D, scr, r, lane); continue; } r -= I_UP;
            if (r < I_DN) { p0_transpose_item(w_down, D, Wdn_t, FF, scr, r, lane); continue; } r -= I_DN;
            p0_weff_item(w_pool, pool_scale, w_out, Wo_t, r, lane);
        }
        __syncthreads();
        for (int j = G - 1 - bx; j < NMOD / 64; j += G) p0_mod_item(lds, c, w_ada, b_ada, mod, j, tid, wave, lane);
    }
    SEAM(0);
    if (IN(1)) norm_mod_rows(x, U, norm_mix_w, mod, 0, D, gw, ngw, lane);
    SEAM(1);
    if (IN(2)) {
        pg8::Gemm g{U, Win_t, M, DIN, D}; pg8::StaticOrder S; S.init(M, DIN, G, bx);
        pg8::EpiBf16<0> E{PROJ, DIN, nullptr, 0, 0, 1.f};
        pg8::gemm_phase<pg8::EpiBf16<0>, pg8::StaticOrder, true, true>(lds, g, S, E);
    }
    SEAM(2);
    if (IN(3)) {
        const int nh = (G >= 256) ? 128 : G;
        if (bx < nh) for (int u = bx; u < BATCH * NH; u += nh) hgrn_mfma_unit(lds, PROJ, MIX, lb_logits, g_norm_w, u, wave, lane);
        if (G >= 256) { if (bx >= 128) pool_items(PROJ, MIX, bx - 128, G - 128, tid); }
        else pool_items(PROJ, MIX, bx, G, tid);
    }
    SEAM(3);
    if (IN(4)) {
        pg8::Gemm g{MIX, Wo_t, M, D, D}; pg8::StaticOrder S; S.init(M, D, G, bx);
        pg8::EpiResGate E{x, out, mod + 2 * D, D, NMOD, T / 256};
        pg8::gemm_phase<pg8::EpiResGate, pg8::StaticOrder, true, true>(lds, g, S, E);
    }
    SEAM(4);
    if (IN(5)) norm_mod_rows(out, U, norm_mlp_w, mod, 3 * D, 4 * D, gw, ngw, lane);
    SEAM(5);
    if (IN(6)) {
        pg8::Gemm g{U, Wup_t, M, FF, D}; pg8::StaticOrder S; S.init(M, FF, G, bx);
        pg8::EpiBf16<2> E{HID, FF, nullptr, 0, 0, 1.f};
        pg8::gemm_phase<pg8::EpiBf16<2>, pg8::StaticOrder, true, true>(lds, g, S, E);
    }
    SEAM(6);
    if (IN(7)) {
        pg8::Gemm g{HID, Wdn_t, M, D, FF}; pg8::StaticOrder S; S.init(M, D, G, bx);
        pg8::EpiResGate E{out, out, mod + 5 * D, D, NMOD, T / 256};
        pg8::gemm_phase<pg8::EpiResGate, pg8::StaticOrder, true, true>(lds, g, S, E);
    }
    SEAM(7);
    if (IN(8)) norm_final_rows(out, norm_final_w, gw, ngw, lane);
#undef IN
#undef SEAM
}

extern "C" void kernel_launch(void* const* d_in, const int* in_sizes, int n_in, void* d_out, int out_size, void* d_ws, size_t ws_size, hipStream_t stream) {
    static int grid = 0;
    if (grid == 0) {
        if (n_in != 15 || in_sizes[0] != M * D || out_size != M * D || ws_size < WS_END) { fprintf(stderr, "kernel_launch: unexpected shapes (n_in %d, in0 %d, out %d, ws %zu)\n", n_in, n_in > 0 ? in_sizes[0] : -1, out_size, ws_size); grid = -1; return; }
        int dev = 0, cus = 0, per_cu = 0;
        (void)hipGetDevice(&dev);
        (void)hipDeviceGetAttribute(&cus, hipDeviceAttributeMultiprocessorCount, dev);
        if (hipFuncSetAttribute((const void*)fwd_megakernel, hipFuncAttributeMaxDynamicSharedMemorySize, LDS_BYTES) != hipSuccess) fprintf(stderr, "kernel_launch: hipFuncSetAttribute failed\n");
        if (hipOccupancyMaxActiveBlocksPerMultiprocessor(&per_cu, (const void*)fwd_megakernel, NTHREADS, LDS_BYTES) != hipSuccess || per_cu < 1) { fprintf(stderr, "kernel_launch: occupancy query says %d\n", per_cu); per_cu = 1; }
        (void)hipGetLastError();
        if (per_cu > 1) per_cu = 1;
        grid = cus * per_cu;
        if (grid <= 0) grid = 256;
    }
    if (grid < 0) return;
    Args a{};
    for (int i = 0; i < 15; ++i) a.in[i] = (const float*)d_in[i];
    a.out = (float*)d_out; a.ws = (unsigned char*)d_ws;
#if MK_N_LAUNCHES == 1
    a.ph_lo = 0; a.ph_hi = N_PHASES;
    void* kargs[] = {&a};
    hipError_t e = hipLaunchCooperativeKernel((const void*)fwd_megakernel, dim3(grid), dim3(NTHREADS), kargs, LDS_BYTES, stream);
    if (e != hipSuccess) fprintf(stderr, "kernel_launch: cooperative launch failed: %s (grid %d)\n", hipGetErrorString(e), grid);
#else
    for (int p = 0; p < N_PHASES; ++p) { a.ph_lo = p; a.ph_hi = p + 1; hipLaunchKernelGGL(fwd_megakernel, dim3(grid), dim3(NTHREADS), LDS_BYTES, stream, a); }
#endif
}
```
